# Optimizing an MI355X kernel written in HIP

```python
import jax, jax.numpy as jnp
from jax import lax
import numpy as np

D_MODEL = 1024
BATCH = 4
SEQ = 8192
DEPTH = 2

N_A_LAYERS = max(1, DEPTH // 2)
N_B_LAYERS = DEPTH - N_A_LAYERS
HEAD_DIM = 64
N_HEADS_A = D_MODEL // HEAD_DIM
N_HEADS_B = D_MODEL // HEAD_DIM
DECAY_LORA = 64
AAA_LORA = 64
GATE_LORA = 160
N_SHIFT_MIX = 6
FFN_HIDDEN = -(-8 * D_MODEL // (3 * 256)) * 256
MOBA_BLOCK = 256
MOBA_TOPK = 3
Q_CHUNK = 16
NORM_EPS = 1e-6
GN_EPS = 64e-5
L2_EPS = 1e-12

kernel_name = "yoco_rwkv7_moba_hybrid"


def rms_norm(x, g):
    xf = x.astype(jnp.float32)
    y = xf * lax.rsqrt(jnp.mean(xf * xf, axis=-1, keepdims=True) + NORM_EPS)
    return (y * g.astype(jnp.float32)).astype(x.dtype)


def ada_params(c, w, b, n):
    m = jax.nn.silu(c) @ w + b
    return jnp.split(m[:, None, :], n, axis=-1)


def swiglu(h, w_gate, w_up, w_down):
    return (jax.nn.silu(h @ w_gate) * (h @ w_up)) @ w_down


def _rwkv7_step(S, inp):
    r, w, k, v, a, b = inp
    sa = jnp.einsum('bhij,bhj->bhi', S, a)
    S = S * w[:, :, None, :] + sa[..., None] * b[:, :, None, :] + v[..., None] * k[:, :, None, :]
    y = jnp.einsum('bhij,bhj->bhi', S, r)
    return S, y


def rwkv7_time_mix(h, mu, w_rkv, w0, w1, w2, a0, a1, a2, g1, g2, k_k, k_a, r_k, lnx_g, lnx_b, w_o):
    B, T, D = h.shape
    H, N = N_HEADS_A, HEAD_DIM
    heads = lambda z: z.reshape(B, T, H, N)
    h_prev = jnp.pad(h, ((0, 0), (1, 0), (0, 0)))[:, :-1]
    xs = h[None] + (h_prev - h)[None] * mu[:, None, None, :]
    r, k, v = jnp.einsum('sbtd,sde->sbte', xs[:3], w_rkv)
    xw, xa, xg = xs[3], xs[4], xs[5]
    w = -jax.nn.softplus(-(w0 + jnp.tanh(xw @ w1) @ w2)) - 0.5
    a = jax.nn.sigmoid(a0 + (xa @ a1) @ a2)
    g = jax.nn.sigmoid(xg @ g1) @ g2
    kk = heads(k * k_k).astype(jnp.float32)
    kk = kk / jnp.maximum(jnp.sqrt(jnp.sum(kk * kk, axis=-1, keepdims=True)), L2_EPS)
    k = k * (1 + (a - 1) * k_a)
    decay = jnp.exp(-jnp.exp(w.astype(jnp.float32)))
    tm = lambda z: heads(z).astype(jnp.float32).transpose(1, 0, 2, 3)
    kk_t = kk.transpose(1, 0, 2, 3)
    seqs = (tm(r), tm(decay), tm(k), tm(v), -kk_t, kk_t * tm(a))
    S0 = jnp.zeros((B, H, N, N), jnp.float32)
    _, y = lax.scan(_rwkv7_step, S0, seqs)
    y = y.transpose(1, 0, 2, 3)
    mean = jnp.mean(y, axis=-1, keepdims=True)
    var = jnp.mean(jnp.square(y - mean), axis=-1, keepdims=True)
    yn = ((y - mean) * lax.rsqrt(var + GN_EPS)).reshape(B, T, D)
    yn = (yn * lnx_g.astype(jnp.float32) + lnx_b.astype(jnp.float32)).astype(h.dtype)
    bonus = jnp.sum(heads(r) * heads(k) * r_k, axis=-1, keepdims=True) * heads(v)
    return ((yn + bonus.reshape(B, T, D)) * g) @ w_o


def shared_kv(x, c, kv_norm_g, kv_w_ada, kv_b_ada, kv_w_k, kv_w_v, k_norm_g):
    B, T, D = x.shape
    H, HD = N_HEADS_B, HEAD_DIM
    shift, scale = ada_params(c, kv_w_ada, kv_b_ada, 2)
    h = rms_norm(x, kv_norm_g) * (1 + scale) + shift
    k = rms_norm((h @ kv_w_k).reshape(B, T, H, HD), k_norm_g)
    v = (h @ kv_w_v).reshape(B, T, H, HD)
    nb = -(-T // MOBA_BLOCK)
    pad = nb * MOBA_BLOCK - T
    to_blocks = lambda z: jnp.pad(z, ((0, 0), (0, pad), (0, 0), (0, 0))).reshape(
        B, nb, MOBA_BLOCK, H, HD).transpose(0, 3, 1, 2, 4)
    kb, vb = to_blocks(k), to_blocks(v)
    kmean = jnp.mean(kb.astype(jnp.float32), axis=3).astype(kb.dtype)
    return kb, vb, kmean


def moba_attention(h, w_q, q_norm_g, kb, vb, kmean, w_o):
    B, T, D = h.shape
    H, HD = N_HEADS_B, HEAD_DIM
    nb = kb.shape[2]
    topk = min(MOBA_TOPK, nb)
    nc = T // Q_CHUNK
    sm_scale = HEAD_DIM ** -0.5
    q = rms_norm((h @ w_q).reshape(B, T, H, HD), q_norm_g)
    q_chunks = q.reshape(B, nc, Q_CHUNK, H, HD).transpose(1, 0, 3, 2, 4)
    bi = jnp.arange(B)[:, None, None, None]
    hi = jnp.arange(H)[None, :, None, None]
    slot = jnp.arange(topk)
    blocks = jnp.arange(nb)
    key_off = jnp.arange(MOBA_BLOCK)
    q_off = jnp.arange(Q_CHUNK)

    def chunk(args):
        qc, ci = args
        t0 = ci * Q_CHUNK
        blk = t0 // MOBA_BLOCK
        gate = jnp.einsum('bhqd,bhnd->bhqn', qc, kmean).astype(jnp.float32)
        gate = jnp.where(blocks < blk, gate, -jnp.inf)
        _, idx = lax.top_k(gate, topk)
        k_sel = kb[bi, hi, idx]
        v_sel = vb[bi, hi, idx]
        s_sel = jnp.einsum('bhqd,bhqskd->bhqsk', qc, k_sel).astype(jnp.float32) * sm_scale
        s_sel = jnp.where((slot < blk)[:, None], s_sel, -jnp.inf)
        k_own = lax.dynamic_index_in_dim(kb, blk, axis=2, keepdims=False)
        v_own = lax.dynamic_index_in_dim(vb, blk, axis=2, keepdims=False)
        s_own = jnp.einsum('bhqd,bhkd->bhqk', qc, k_own).astype(jnp.float32) * sm_scale
        causal = (blk * MOBA_BLOCK + key_off)[None, :] <= (t0 + q_off)[:, None]
        s_own = jnp.where(causal, s_own, -jnp.inf)
        s = jnp.concatenate([s_sel.reshape(B, H, Q_CHUNK, topk * MOBA_BLOCK), s_own], axis=-1)
        p = jax.nn.softmax(s, axis=-1).astype(vb.dtype)
        p_sel = p[..., :topk * MOBA_BLOCK].reshape(B, H, Q_CHUNK, topk, MOBA_BLOCK)
        p_own = p[..., topk * MOBA_BLOCK:]
        return (jnp.einsum('bhqsk,bhqskd->bhqd', p_sel, v_sel)
                + jnp.einsum('bhqk,bhkd->bhqd', p_own, v_own))

    o = lax.map(chunk, (q_chunks, jnp.arange(nc)))
    o = o.transpose(1, 0, 3, 2, 4).reshape(B, T, D)
    return o @ w_o


def setup_inputs(seed: int = 0) -> dict:
    key = jax.random.key(seed)
    ks = iter(jax.random.split(key, 40))
    f32 = jnp.float32
    D, F, NA, NBL, HD = D_MODEL, FFN_HIDDEN, N_A_LAYERS, N_B_LAYERS, HEAD_DIM
    nrm = lambda shape, s: jax.random.normal(next(ks), shape, f32) * s
    uni = lambda shape, lo, hi: jax.random.uniform(next(ks), shape, f32, lo, hi)
    return {
        "x": nrm((BATCH, SEQ, D), 1.0),
        "c": nrm((BATCH, D), 1.0),
        "norm_g": 1.0 + nrm((DEPTH, 2, D), 0.1),
        "w_ada": nrm((DEPTH, 2, D, 3 * D), 0.5 * D ** -0.5),
        "b_ada": nrm((DEPTH, 2, 3 * D), 0.02),
        "rw_mu": uni((NA, N_SHIFT_MIX, D), 0.0, 1.0),
        "rw_w_rkv": nrm((NA, 3, D, D), D ** -0.5),
        "rw_w0": uni((NA, D), -6.0, 0.0),
        "rw_w1": nrm((NA, D, DECAY_LORA), D ** -0.5),
        "rw_w2": nrm((NA, DECAY_LORA, D), 0.5 * DECAY_LORA ** -0.5),
        "rw_a0": nrm((NA, D), 0.5),
        "rw_a1": nrm((NA, D, AAA_LORA), D ** -0.5),
        "rw_a2": nrm((NA, AAA_LORA, D), AAA_LORA ** -0.5),
        "rw_g1": nrm((NA, D, GATE_LORA), D ** -0.5),
        "rw_g2": nrm((NA, GATE_LORA, D), GATE_LORA ** -0.5),
        "rw_k_k": 0.85 + nrm((NA, D), 0.1),
        "rw_k_a": 1.0 + nrm((NA, D), 0.1),
        "rw_r_k": nrm((NA, N_HEADS_A, HD), 0.1),
        "rw_lnx_g": 1.0 + nrm((NA, D), 0.1),
        "rw_lnx_b": nrm((NA, D), 0.02),
        "rw_w_o": nrm((NA, D, D), D ** -0.5),
        "ffn_w_gate": nrm((DEPTH, D, F), D ** -0.5),
        "ffn_w_up": nrm((DEPTH, D, F), D ** -0.5),
        "ffn_w_down": nrm((DEPTH, F, D), F ** -0.5),
        "kv_norm_g": 1.0 + nrm((D,), 0.1),
        "kv_w_ada": nrm((D, 2 * D), 0.5 * D ** -0.5),
        "kv_b_ada": nrm((2 * D,), 0.02),
        "kv_w_k": nrm((D, D), D ** -0.5),
        "kv_w_v": nrm((D, D), D ** -0.5),
        "k_norm_g": 1.0 + nrm((HD,), 0.1),
        "mb_w_q": nrm((NBL, D, D), D ** -0.5),
        "mb_q_norm_g": 1.0 + nrm((NBL, HD), 0.1),
        "mb_w_o": nrm((NBL, D, D), D ** -0.5),
    }


def reference(x, c, norm_g, w_ada, b_ada, rw_mu, rw_w_rkv, rw_w0, rw_w1, rw_w2, rw_a0, rw_a1, rw_a2,
              rw_g1, rw_g2, rw_k_k, rw_k_a, rw_r_k, rw_lnx_g, rw_lnx_b, rw_w_o,
              ffn_w_gate, ffn_w_up, ffn_w_down, kv_norm_g, kv_w_ada, kv_b_ada, kv_w_k, kv_w_v,
              k_norm_g, mb_w_q, mb_q_norm_g, mb_w_o):
    kb = vb = kmean = None
    for i in range(DEPTH):
        shift, scale, gate = ada_params(c, w_ada[i, 0], b_ada[i, 0], 3)
        h = rms_norm(x, norm_g[i, 0]) * (1 + scale) + shift
        if i < N_A_LAYERS:
            j = i
            mix = rwkv7_time_mix(h, rw_mu[j], rw_w_rkv[j], rw_w0[j], rw_w1[j], rw_w2[j],
                                 rw_a0[j], rw_a1[j], rw_a2[j], rw_g1[j], rw_g2[j],
                                 rw_k_k[j], rw_k_a[j], rw_r_k[j], rw_lnx_g[j], rw_lnx_b[j], rw_w_o[j])
        else:
            j = i - N_A_LAYERS
            mix = moba_attention(h, mb_w_q[j], mb_q_norm_g[j], kb, vb, kmean, mb_w_o[j])
        x = x + gate * mix
        shift, scale, gate = ada_params(c, w_ada[i, 1], b_ada[i, 1], 3)
        h = rms_norm(x, norm_g[i, 1]) * (1 + scale) + shift
        x = x + gate * swiglu(h, ffn_w_gate[i], ffn_w_up[i], ffn_w_down[i])
        if i == N_A_LAYERS - 1:
            kb, vb, kmean = shared_kv(x, c, kv_norm_g, kv_w_ada, kv_b_ada, kv_w_k, kv_w_v, k_norm_g)
    return x
```

```cpp
#include <hip/hip_runtime.h>
#include <hip/hip_cooperative_groups.h>
#include <cstdio>
namespace cg = cooperative_groups;

typedef unsigned short u16;
typedef __attribute__((ext_vector_type(8))) short bf16x8;
typedef __attribute__((ext_vector_type(4))) float f32x4;

#ifndef SINGLE_LAUNCH
#define SINGLE_LAUNCH 1
#endif

constexpr int NT = 512;
constexpr int NWV = 8;
constexpr int DM = 1024, NB = 4, TT = 8192, MT = NB * TT, FF = 2816, NH = 16;
constexpr int MODLD = 14336;
constexpr size_t MiB = 1u << 20;
constexpr size_t M1 = 1048576;

constexpr size_t WT_RKV = 0;
constexpr size_t WT_W1 = WT_RKV + 3 * M1;
constexpr size_t WT_A1 = WT_W1 + 256 * 1024;
constexpr size_t WT_G1 = WT_A1 + 256 * 1024;
constexpr size_t WT_W2 = WT_G1 + 256 * 1024;
constexpr size_t WT_A2 = WT_W2 + 256 * 1024;
constexpr size_t WT_G2 = WT_A2 + 256 * 1024;
constexpr size_t WT_WO = WT_G2 + 256 * 1024;
constexpr size_t WT_GU = WT_WO + M1;
constexpr size_t WT_DN = WT_GU + 2 * 5632 * 1024;
constexpr size_t WT_KVK = WT_DN + 2 * 1024 * 2816;
constexpr size_t WT_KVV = WT_KVK + M1;
constexpr size_t WT_Q = WT_KVV + M1;
constexpr size_t WT_MBO = WT_Q + M1;
constexpr size_t WT_END = WT_MBO + M1;
static_assert(WT_END * 2 <= 52 * MiB, "wt region");
constexpr size_t OFF_MOD = 52 * MiB;
constexpr size_t OFF_CNT = OFF_MOD + 4 * MODLD * 4;
constexpr size_t OFF_KMEAN = OFF_CNT + 2048 * 4;
constexpr size_t OFF_LSE = 53 * MiB;
constexpr size_t OFF_SLOT0 = 64 * MiB;
#define SLOT(i) (OFF_SLOT0 + (size_t)(i) * 64 * MiB)
#define DSLOT(p, i) ((unsigned char*)(p).out + (size_t)(i) * 64 * MiB)

constexpr int STG_LD = 132;
constexpr int STG_BYTES = 128 * STG_LD * 4;
constexpr int SMEM_BYTES = 2 * STG_BYTES + 256;

struct Params {
  const float* in[33];
  float* out;
  unsigned char* ws;
};

typedef __bf16 bf2v __attribute__((ext_vector_type(2)));
typedef float f2v __attribute__((ext_vector_type(2)));
__device__ __forceinline__ unsigned pack2(float a, float b) {
  f2v f = {a, b};
  bf2v r = __builtin_convertvector(f, bf2v);
  return __builtin_bit_cast(unsigned, r);
}
__device__ __forceinline__ u16 f2bf(float f) { return (u16)(pack2(f, 0.f) & 0xffffu); }
__device__ __forceinline__ float bf2f(u16 h) { return __uint_as_float(((unsigned)h) << 16); }
__device__ __forceinline__ float bflo(unsigned x) { return __uint_as_float(x << 16); }
__device__ __forceinline__ float bfhi(unsigned x) { return __uint_as_float(x & 0xffff0000u); }
__device__ __forceinline__ float frcp_(float x) { return __builtin_amdgcn_rcpf(x); }
__device__ __forceinline__ float sigmoidf_(float x) { return frcp_(1.f + __expf(-x)); }
__device__ __forceinline__ float siluf_(float x) { return x * frcp_(1.f + __expf(-x)); }
__device__ __forceinline__ float tanhf_(float x) { return 1.f - 2.f * frcp_(1.f + __expf(2.f * x)); }

template <int CTRL>
__device__ __forceinline__ float dppf(float x) {
  return __int_as_float(__builtin_amdgcn_update_dpp(0, __float_as_int(x), CTRL, 0xF, 0xF, true));
}
__device__ __forceinline__ float allreduce16(float x) {
  x += dppf<0xB1>(x);
  x += dppf<0x4E>(x);
  x += dppf<0x124>(x);
  x += dppf<0x128>(x);
  return x;
}
__device__ __forceinline__ float wave_sum(float x) {
#pragma unroll
  for (int o = 32; o >= 1; o >>= 1) x += __shfl_xor(x, o);
  return x;
}

__device__ __forceinline__ void unpack8(uint4 u, float* f) {
  f[0] = bflo(u.x); f[1] = bfhi(u.x); f[2] = bflo(u.y); f[3] = bfhi(u.y);
  f[4] = bflo(u.z); f[5] = bfhi(u.z); f[6] = bflo(u.w); f[7] = bfhi(u.w);
}
__device__ __forceinline__ uint4 pack8(const float* f) {
  uint4 o; o.x = pack2(f[0], f[1]); o.y = pack2(f[2], f[3]); o.z = pack2(f[4], f[5]); o.w = pack2(f[6], f[7]); return o;
}

struct TJob { const float* src; u16* dst; int K, N, Kp, Np, mode, which; };

__device__ __forceinline__ TJob get_job(const Params& p, int j) {
  u16* wt = (u16*)p.ws;
  TJob t;
  t.mode = 0; t.which = 0;
  switch (j) {
    case 0: t.src = p.in[6]; t.dst = wt + WT_RKV; t.K = 1024; t.N = 1024; t.Kp = 1024; t.Np = 1024; break;
    case 1: t.src = p.in[6] + M1; t.dst = wt + WT_RKV + M1; t.K = 1024; t.N = 1024; t.Kp = 1024; t.Np = 1024; break;
    case 2: t.src = p.in[6] + 2 * M1; t.dst = wt + WT_RKV + 2 * M1; t.K = 1024; t.N = 1024; t.Kp = 1024; t.Np = 1024; break;
    case 3: t.src = p.in[8]; t.dst = wt + WT_W1; t.K = 1024; t.N = 64; t.Kp = 1024; t.Np = 256; break;
    case 4: t.src = p.in[11]; t.dst = wt + WT_A1; t.K = 1024; t.N = 64; t.Kp = 1024; t.Np = 256; break;
    case 5: t.src = p.in[13]; t.dst = wt + WT_G1; t.K = 1024; t.N = 160; t.Kp = 1024; t.Np = 256; break;
    case 6: t.src = p.in[9]; t.dst = wt + WT_W2; t.K = 64; t.N = 1024; t.Kp = 256; t.Np = 1024; break;
    case 7: t.src = p.in[12]; t.dst = wt + WT_A2; t.K = 64; t.N = 1024; t.Kp = 256; t.Np = 1024; break;
    case 8: t.src = p.in[14]; t.dst = wt + WT_G2; t.K = 160; t.N = 1024; t.Kp = 256; t.Np = 1024; break;
    case 9: t.src = p.in[20]; t.dst = wt + WT_WO; t.K = 1024; t.N = 1024; t.Kp = 1024; t.Np = 1024; break;
    case 10: t.src = p.in[21]; t.dst = wt + WT_GU; t.K = 1024; t.N = 2816; t.Kp = 1024; t.Np = 2816; t.mode = 1; t.which = 0; break;
    case 11: t.src = p.in[22]; t.dst = wt + WT_GU; t.K = 1024; t.N = 2816; t.Kp = 1024; t.Np = 2816; t.mode = 1; t.which = 1; break;
    case 12: t.src = p.in[21] + (size_t)1024 * 2816; t.dst = wt + WT_GU + (size_t)5632 * 1024; t.K = 1024; t.N = 2816; t.Kp = 1024; t.Np = 2816; t.mode = 1; t.which = 0; break;
    case 13: t.src = p.in[22] + (size_t)1024 * 2816; t.dst = wt + WT_GU + (size_t)5632 * 1024; t.K = 1024; t.N = 2816; t.Kp = 1024; t.Np = 2816; t.mode = 1; t.which = 1; break;
    case 14: t.src = p.in[23]; t.dst = wt + WT_DN; t.K = 2816; t.N = 1024; t.Kp = 2816; t.Np = 1024; break;
    case 15: t.src = p.in[23] + (size_t)1024 * 2816; t.dst = wt + WT_DN + (size_t)1024 * 2816; t.K = 2816; t.N = 1024; t.Kp = 2816; t.Np = 1024; break;
    case 16: t.src = p.in[27]; t.dst = wt + WT_KVK; t.K = 1024; t.N = 1024; t.Kp = 1024; t.Np = 1024; break;
    case 17: t.src = p.in[28]; t.dst = wt + WT_KVV; t.K = 1024; t.N = 1024; t.Kp = 1024; t.Np = 1024; break;
    case 18: t.src = p.in[30]; t.dst = wt + WT_Q; t.K = 1024; t.N = 1024; t.Kp = 1024; t.Np = 1024; break;
    default: t.src = p.in[32]; t.dst = wt + WT_MBO; t.K = 1024; t.N = 1024; t.Kp = 1024; t.Np = 1024; break;
  }
  return t;
}
constexpr int NJOBS = 20;

__device__ __forceinline__ void phase_prep(const Params& p, unsigned char* smem) {
  const int tid = threadIdx.x;
  if (blockIdx.x == 0) {
    int* cnt = (int*)(p.ws + OFF_CNT);
    for (int i = tid; i < 2048; i += NT) cnt[i] = 0;
  }
  int total = 0;
  for (int j = 0; j < NJOBS; ++j) { TJob t = get_job(p, j); total += (t.Np >> 6) * (t.Kp >> 6); }
  float (*tile)[65] = (float (*)[65])smem;
  const int NADA = MODLD / 64;
  auto decode_tile = [&](int it_, TJob& t, int& n0, int& k0) {
    int j = 0, lt = it_;
    t = get_job(p, 0);
    while (true) {
      int n = (t.Np >> 6) * (t.Kp >> 6);
      if (lt < n) break;
      lt -= n; ++j; t = get_job(p, j);
    }
    const int nkt = t.Kp >> 6;
    n0 = (lt / nkt) * 64; k0 = (lt % nkt) * 64;
  };
  auto tile_load = [&](const TJob& t, int n0, int k0, float4& v0, float4& v1) {
    {
      const int kk = tid >> 4, n4 = (tid & 15) * 4;
      const int k = k0 + kk, n = n0 + n4;
      v0 = make_float4(0.f, 0.f, 0.f, 0.f);
      if (k < t.K && n < t.N) v0 = *(const float4*)(t.src + (size_t)k * t.N + n);
    }
    {
      const int kk = (tid + NT) >> 4, n4 = (tid & 15) * 4;
      const int k = k0 + kk, n = n0 + n4;
      v1 = make_float4(0.f, 0.f, 0.f, 0.f);
      if (k < t.K && n < t.N) v1 = *(const float4*)(t.src + (size_t)k * t.N + n);
    }
  };
  int it = blockIdx.x;
  {
    TJob t; int n0 = 0, k0 = 0; float4 v0, v1;
    if (it < total) { decode_tile(it, t, n0, k0); tile_load(t, n0, k0, v0, v1); }
    while (it < total) {
      {
        const int kk = tid >> 4, n4 = (tid & 15) * 4;
        tile[kk][n4] = v0.x; tile[kk][n4 + 1] = v0.y; tile[kk][n4 + 2] = v0.z; tile[kk][n4 + 3] = v0.w;
        tile[kk + 32][n4] = v1.x; tile[kk + 32][n4 + 1] = v1.y; tile[kk + 32][n4 + 2] = v1.z; tile[kk + 32][n4 + 3] = v1.w;
      }
      __syncthreads();
      const int itn = it + gridDim.x;
      TJob tn = t; int n0n = n0, k0n = k0;
      if (itn < total) { decode_tile(itn, tn, n0n, k0n); tile_load(tn, n0n, k0n, v0, v1); }
      {
        const int nn = tid >> 3, kk0 = (tid & 7) * 8;
        const int n = n0 + nn;
        const int drow = t.mode ? ((n >> 4) * 32 + t.which * 16 + (n & 15)) : n;
        float f[8];
#pragma unroll
        for (int q = 0; q < 8; ++q) f[q] = tile[kk0 + q][nn];
        *(uint4*)(t.dst + (size_t)drow * t.Kp + k0 + kk0) = pack8(f);
      }
      __syncthreads();
      t = tn; n0 = n0n; k0 = k0n; it = itn;
    }
  }
  for (; it < total + NADA; it += gridDim.x) {
    {
      const int a = it - total;
      const int ncol0 = a * 64;
      const float* W; const float* bias; int ldw, nl0;
      if (ncol0 < 12288) {
        int g = ncol0 / 3072;
        W = p.in[3] + (size_t)g * 1024 * 3072; bias = p.in[4] + g * 3072; ldw = 3072; nl0 = ncol0 - g * 3072;
      } else {
        W = p.in[25]; bias = p.in[26]; ldw = 2048; nl0 = ncol0 - 12288;
      }
      float* sc = (float*)smem;
      float* red = (float*)(smem + 16384);
      const float* c = p.in[1];
      for (int i = tid; i < 4096; i += NT) sc[i] = siluf_(c[i]);
      __syncthreads();
      const int w = tid >> 6, lane = tid & 63;
      float a0 = 0, a1 = 0, a2 = 0, a3 = 0;
      const float* wp = W + (size_t)(w * 128) * ldw + nl0 + lane;
#pragma unroll 8
      for (int k = 0; k < 128; ++k) {
        float wv = wp[(size_t)k * ldw];
        int kk = w * 128 + k;
        a0 += sc[kk] * wv; a1 += sc[1024 + kk] * wv; a2 += sc[2048 + kk] * wv; a3 += sc[3072 + kk] * wv;
      }
      red[(w * 4 + 0) * 64 + lane] = a0; red[(w * 4 + 1) * 64 + lane] = a1;
      red[(w * 4 + 2) * 64 + lane] = a2; red[(w * 4 + 3) * 64 + lane] = a3;
      __syncthreads();
      if (tid < 256) {
        int b = tid >> 6;
        float s = 0.f;
#pragma unroll
        for (int ww = 0; ww < 8; ++ww) s += red[(ww * 4 + b) * 64 + lane];
        float* mod = (float*)(p.ws + OFF_MOD);
        mod[b * MODLD + ncol0 + lane] = s + bias[nl0 + lane];
      }
      __syncthreads();
    }
  }
}

__device__ __forceinline__ void phase_norm(const float* __restrict__ x, const float* __restrict__ g1, const float* __restrict__ mod,
                           int sh1, int sc1, u16* __restrict__ o1,
                           const float* __restrict__ g2, int sh2, int sc2, u16* __restrict__ o2) {
  const int lane = threadIdx.x & 63;
  const int gw = blockIdx.x * NWV + (threadIdx.x >> 6);
  const int nw = gridDim.x * NWV;
  auto ldrow = [&](int row, float4* v) {
    const float* xp = x + (size_t)row * DM;
#pragma unroll
    for (int ch = 0; ch < 2; ++ch) {
      const int col = (lane + 64 * ch) * 8;
      v[2 * ch] = *(const float4*)(xp + col); v[2 * ch + 1] = *(const float4*)(xp + col + 4);
    }
  };
  auto emit = [&](const float* xv, float rs, const float* gp, const float* shp, const float* scp, u16* op) {
    float4 g0 = *(const float4*)gp, g1_ = *(const float4*)(gp + 4);
    float4 s0 = *(const float4*)shp, s1 = *(const float4*)(shp + 4);
    float4 c0 = *(const float4*)scp, c1 = *(const float4*)(scp + 4);
    const float gg[8] = {g0.x, g0.y, g0.z, g0.w, g1_.x, g1_.y, g1_.z, g1_.w};
    const float sh[8] = {s0.x, s0.y, s0.z, s0.w, s1.x, s1.y, s1.z, s1.w};
    const float sc[8] = {c0.x, c0.y, c0.z, c0.w, c1.x, c1.y, c1.z, c1.w};
    float o[8];
#pragma unroll
    for (int e = 0; e < 8; ++e) o[e] = xv[e] * rs * gg[e] * (1.f + sc[e]) + sh[e];
    *(uint4*)op = pack8(o);
  };
  float4 v[4];
  int row = gw;
  if (row < MT) ldrow(row, v);
  for (; row < MT; row += nw) {
    float4 vn[4];
    const int rn = row + nw;
    ldrow(rn < MT ? rn : row, vn);
    __builtin_amdgcn_sched_barrier(0);
    float ss = 0.f;
#pragma unroll
    for (int i = 0; i < 4; ++i) ss += v[i].x * v[i].x + v[i].y * v[i].y + v[i].z * v[i].z + v[i].w * v[i].w;
    ss = wave_sum(ss);
    const float rs = rsqrtf(ss * (1.f / DM) + 1e-6f);
    const float* mb = mod + (size_t)(row >> 13) * MODLD;
#pragma unroll
    for (int ch = 0; ch < 2; ++ch) {
      const int col = (lane + 64 * ch) * 8;
      const float xv[8] = {v[2 * ch].x, v[2 * ch].y, v[2 * ch].z, v[2 * ch].w, v[2 * ch + 1].x, v[2 * ch + 1].y, v[2 * ch + 1].z, v[2 * ch + 1].w};
      emit(xv, rs, g1 + col, mb + sh1 + col, mb + sc1 + col, o1 + (size_t)row * DM + col);
      if (o2) emit(xv, rs, g2 + col, mb + sh2 + col, mb + sc2 + col, o2 + (size_t)row * DM + col);
    }
#pragma unroll
    for (int i = 0; i < 4; ++i) v[i] = vn[i];
  }
}

__device__ __forceinline__ void phase_norm_xs(const Params& p) {
  const float* x = p.in[0];
  const float* g1 = p.in[2];
  const float* mod = (const float*)(p.ws + OFF_MOD);
  const float* mu = p.in[5];
  const int lane = threadIdx.x & 63;
  const int gw = blockIdx.x * NWV + (threadIdx.x >> 6);
  const int nw = gridDim.x * NWV;
  float muv[6][2][8];
#pragma unroll
  for (int ch = 0; ch < 2; ++ch) {
    const int col = (lane + 64 * ch) * 8;
#pragma unroll
    for (int s6 = 0; s6 < 6; ++s6) {
      float4 m0 = *(const float4*)(mu + s6 * DM + col), m1 = *(const float4*)(mu + s6 * DM + col + 4);
      muv[s6][ch][0] = m0.x; muv[s6][ch][1] = m0.y; muv[s6][ch][2] = m0.z; muv[s6][ch][3] = m0.w;
      muv[s6][ch][4] = m1.x; muv[s6][ch][5] = m1.y; muv[s6][ch][6] = m1.z; muv[s6][ch][7] = m1.w;
    }
  }
  auto ldrow = [&](int row, float4* v, float4* u) {
    const bool first = (row & (TT - 1)) == 0;
    const float* xp = x + (size_t)row * DM;
    const float* xq = x + (size_t)(first ? row : row - 1) * DM;
#pragma unroll
    for (int ch = 0; ch < 2; ++ch) {
      const int col = (lane + 64 * ch) * 8;
      v[2 * ch] = *(const float4*)(xp + col); v[2 * ch + 1] = *(const float4*)(xp + col + 4);
      u[2 * ch] = *(const float4*)(xq + col); u[2 * ch + 1] = *(const float4*)(xq + col + 4);
    }
  };
  float4 v[4], u[4];
  int row = gw;
  if (row < MT) ldrow(row, v, u);
  for (; row < MT; row += nw) {
    float4 vn[4], un[4];
    const int rn = row + nw;
    ldrow(rn < MT ? rn : row, vn, un);
    __builtin_amdgcn_sched_barrier(0);
    const bool first = (row & (TT - 1)) == 0;
    float ss = 0.f, st = 0.f;
#pragma unroll
    for (int i = 0; i < 4; ++i) {
      ss += v[i].x * v[i].x + v[i].y * v[i].y + v[i].z * v[i].z + v[i].w * v[i].w;
      st += u[i].x * u[i].x + u[i].y * u[i].y + u[i].z * u[i].z + u[i].w * u[i].w;
    }
    ss = wave_sum(ss); st = wave_sum(st);
    const float rs = rsqrtf(ss * (1.f / DM) + 1e-6f);
    const float rt = first ? 0.f : rsqrtf(st * (1.f / DM) + 1e-6f);
    const float* mb = mod + (size_t)(row >> 13) * MODLD;
#pragma unroll
    for (int ch = 0; ch < 2; ++ch) {
      const int col = (lane + 64 * ch) * 8;
      float4 sh0 = *(const float4*)(mb + col), sh1 = *(const float4*)(mb + col + 4);
      float4 sc0 = *(const float4*)(mb + 1024 + col), sc1 = *(const float4*)(mb + 1024 + col + 4);
      float4 gm0 = *(const float4*)(g1 + col), gm1 = *(const float4*)(g1 + col + 4);
      const float gmv[8] = {gm0.x, gm0.y, gm0.z, gm0.w, gm1.x, gm1.y, gm1.z, gm1.w};
      const float sh[8] = {sh0.x, sh0.y, sh0.z, sh0.w, sh1.x, sh1.y, sh1.z, sh1.w};
      const float sc[8] = {sc0.x, sc0.y, sc0.z, sc0.w, sc1.x, sc1.y, sc1.z, sc1.w};
      const float xv[8] = {v[2 * ch].x, v[2 * ch].y, v[2 * ch].z, v[2 * ch].w, v[2 * ch + 1].x, v[2 * ch + 1].y, v[2 * ch + 1].z, v[2 * ch + 1].w};
      const float uv[8] = {u[2 * ch].x, u[2 * ch].y, u[2 * ch].z, u[2 * ch].w, u[2 * ch + 1].x, u[2 * ch + 1].y, u[2 * ch + 1].z, u[2 * ch + 1].w};
      float h[8], d[8];
#pragma unroll
      for (int e = 0; e < 8; ++e) {
        const float gg = gmv[e] * (1.f + sc[e]);
        h[e] = xv[e] * rs * gg + sh[e];
        const float q = first ? 0.f : (uv[e] * rt * gg + sh[e]);
        d[e] = q - h[e];
      }
#pragma unroll
      for (int s6 = 0; s6 < 6; ++s6) {
        float o[8];
#pragma unroll
        for (int e = 0; e < 8; ++e) o[e] = h[e] + d[e] * muv[s6][ch][e];
        *(uint4*)((u16*)(p.ws + SLOT(s6)) + (size_t)row * DM + col) = pack8(o);
      }
    }
#pragma unroll
    for (int i = 0; i < 4; ++i) { v[i] = vn[i]; u[i] = un[i]; }
  }
}

enum { EPI_BF16 = 0, EPI_TANH, EPI_SIG, EPI_DECAY, EPI_AK, EPI_RESID, EPI_SWIGLU, EPI_HEADNORM, EPI_VT };
struct Epi {
  u16* o16; float* o32; const float* res; const float* gate; int ldo;
  const float* v0; const float* v1; const float* v2;
  u16* kbuf; u16* kkbuf; u16* abbuf;
};

constexpr int G_BK = 64, G_HALF = 128, G_HT = G_HALF * G_BK;

__device__ __forceinline__ int lds_byte(int r, int c) {
  int st = (r >> 4) * 2 + (c >> 5), rr = r & 15, cc = c & 31, ob = rr * 64 + cc * 2;
  return st * 1024 + (ob ^ (((ob >> 9) & 1) << 5));
}
__device__ __forceinline__ void stage_rc(int b, int& R, int& C) {
  int st = b / 1024, sb = b % 1024, swz = sb ^ (((sb >> 9) & 1) << 5);
  R = (st >> 1) * 16 + swz / 64; C = (st & 1) * 32 + (swz % 64) / 2;
}

#define IS(x) ((((EPISET) >> (x)) & 1) && epi == (x))
template <int EPISET>
__device__ __forceinline__ void gemm_tile(const u16* __restrict__ A, const u16* __restrict__ Bt, const int K,
                                          const int brow, const int bcol, const int epi, const Epi& e, unsigned char* smem) {
  u16* shm = (u16*)smem;
#define SA(b, h) (shm + ((b) * 2 + (h)) * G_HT)
#define SB(b, h) (shm + (4 + (b) * 2 + (h)) * G_HT)
#define STAGE(P, BASE, br, kt) do { const char* _gb = (const char*)((BASE) + (long)(br) * K + (long)(kt) * G_BK); \
      __builtin_amdgcn_global_load_lds((const unsigned*)(_gb + (size_t)voff), \
        (__attribute__((address_space(3))) unsigned*)((char*)(P) + threadIdx.x * 16), 16, 0, 0); \
      __builtin_amdgcn_global_load_lds((const unsigned*)(_gb + (size_t)K * 128 + (size_t)voff), \
        (__attribute__((address_space(3))) unsigned*)((char*)(P) + threadIdx.x * 16 + 8192), 16, 0, 0); } while (0)
#define LDA(dst, b, h) for (int m = 0; m < 4; ++m) for (int k = 0; k < 2; ++k) \
    dst[m][k] = *reinterpret_cast<const bf16x8*>((char*)SA(b, h) + lds_byte(wr * 64 + m * 16 + fr, k * 32 + fq * 8))
#define LDB(dst, b, h) for (int n = 0; n < 2; ++n) for (int k = 0; k < 2; ++k) \
    dst[n][k] = *reinterpret_cast<const bf16x8*>((char*)SB(b, h) + lds_byte(wc * 32 + n * 16 + fr, k * 32 + fq * 8))
#define MMA(ai, bj, At_, Bt_) do { __builtin_amdgcn_s_setprio(1); \
    for (int m = 0; m < 4; ++m) for (int n = 0; n < 2; ++n) for (int k = 0; k < 2; ++k) \
      acc[ai][bj][m][n] = __builtin_amdgcn_mfma_f32_16x16x32_bf16(At_[m][k], Bt_[n][k], acc[ai][bj][m][n], 0, 0, 0); \
    __builtin_amdgcn_s_setprio(0); } while (0)
#define WAIT_V(n) asm volatile("s_waitcnt vmcnt(" #n ")" ::: "memory")
#define WAIT_L(n) asm volatile("s_waitcnt lgkmcnt(" #n ")" ::: "memory")
#define BAR __builtin_amdgcn_s_barrier()
#define SCHED __builtin_amdgcn_sched_barrier(0)
  const int tid = threadIdx.x;
  const int wid = tid >> 6, lane = tid & 63, wr = wid >> 2, wc = wid & 3, fr = lane & 15, fq = lane >> 4;
  f32x4 acc[2][2][4][2] = {};
  bf16x8 At[4][2], B0[2][2], B1[2][2];
  int nt = K / G_BK;
  asm volatile("" : "+s"(nt));
  unsigned voff;
  { int _r, _c; stage_rc(tid * 16, _r, _c); voff = (unsigned)(_r * K + _c) * 2u; }
  __syncthreads();
  STAGE(SB(0, 0), Bt, bcol, 0); STAGE(SA(0, 0), A, brow, 0);
  STAGE(SB(0, 1), Bt, bcol + G_HALF, 0); STAGE(SA(0, 1), A, brow + G_HALF, 0);
  if (wr == 1) BAR;
  WAIT_V(4); BAR;
  STAGE(SB(1, 0), Bt, bcol, 1); STAGE(SA(1, 0), A, brow, 1); STAGE(SB(1, 1), Bt, bcol + G_HALF, 1);
  WAIT_V(6); BAR;
#pragma unroll 1
  for (int t = 0; t < nt - 2; t += 2) {
    LDB(B0, 0, 0); SCHED; LDA(At, 0, 0); STAGE(SA(1, 1), A, brow + G_HALF, t + 1);
    WAIT_L(8); BAR; WAIT_L(0); MMA(0, 0, At, B0); BAR; SCHED;
    LDB(B1, 0, 1); STAGE(SB(0, 0), Bt, bcol, t + 2);
    BAR; WAIT_L(0); MMA(0, 1, At, B1); BAR;
    LDA(At, 0, 1); STAGE(SA(0, 0), A, brow, t + 2);
    BAR; WAIT_L(0); MMA(1, 0, At, B0); BAR; SCHED;
    STAGE(SB(0, 1), Bt, bcol + G_HALF, t + 2);
    WAIT_V(6); BAR; MMA(1, 1, At, B1); BAR;
    LDB(B0, 1, 0); SCHED; LDA(At, 1, 0); STAGE(SA(0, 1), A, brow + G_HALF, t + 2);
    WAIT_L(8); BAR; WAIT_L(0); MMA(0, 0, At, B0); BAR; SCHED;
    LDB(B1, 1, 1); STAGE(SB(1, 0), Bt, bcol, t + 3);
    BAR; WAIT_L(0); MMA(0, 1, At, B1); BAR;
    LDA(At, 1, 1); STAGE(SA(1, 0), A, brow, t + 3);
    BAR; WAIT_L(0); MMA(1, 0, At, B0); BAR; SCHED;
    STAGE(SB(1, 1), Bt, bcol + G_HALF, t + 3);
    WAIT_V(6); BAR; MMA(1, 1, At, B1); BAR;
  }
  { LDB(B0, 0, 0); LDA(At, 0, 0); STAGE(SA(1, 1), A, brow + G_HALF, nt - 1);
    BAR; WAIT_L(0); MMA(0, 0, At, B0); BAR;
    LDB(B1, 0, 1); BAR; WAIT_L(0); MMA(0, 1, At, B1); BAR;
    LDA(At, 0, 1); WAIT_V(4); BAR; WAIT_L(0); MMA(1, 0, At, B0); MMA(1, 1, At, B1); BAR; }
  { LDB(B0, 1, 0); LDA(At, 1, 0); WAIT_V(2); BAR; WAIT_L(0); MMA(0, 0, At, B0); BAR;
    LDB(B1, 1, 1); WAIT_V(0); BAR; WAIT_L(0); MMA(0, 1, At, B1); BAR;
    LDA(At, 1, 1); BAR; WAIT_L(0); MMA(1, 0, At, B0); MMA(1, 1, At, B1); BAR; }
  if (wr == 0) BAR;
#undef SA
#undef SB
#undef STAGE
#undef LDA
#undef LDB
#undef MMA
#undef WAIT_V
#undef WAIT_L
#undef BAR
#undef SCHED

  int tid_e;
  asm volatile("v_mov_b32 %0, %1" : "=v"(tid_e) : "v"(tid));
  const int wid_e = tid_e >> 6, lane_e = tid_e & 63, wr_e = wid_e >> 2, wc_e = wid_e & 3, fr_e = lane_e & 15, fq_e = lane_e >> 4;
#pragma unroll
  for (int ai = 0; ai < 2; ++ai)
#pragma unroll
    for (int bj = 0; bj < 2; ++bj) {
      float* stg = (float*)(smem + ((ai * 2 + bj) & 1) * STG_BYTES);
      if (IS(EPI_VT)) {
#pragma unroll
        for (int m = 0; m < 4; ++m)
#pragma unroll
          for (int n = 0; n < 2; ++n) {
            f32x4 a4 = acc[ai][bj][m][n];
            *(float4*)(stg + (wc_e * 32 + n * 16 + fr_e) * STG_LD + wr_e * 64 + m * 16 + fq_e * 4) = make_float4(a4[0], a4[1], a4[2], a4[3]);
          }
      } else {
#pragma unroll
        for (int m = 0; m < 4; ++m)
#pragma unroll
          for (int n = 0; n < 2; ++n)
#pragma unroll
            for (int j = 0; j < 4; ++j)
              stg[(wr_e * 64 + m * 16 + fq_e * 4 + j) * STG_LD + wc_e * 32 + n * 16 + fr_e] = acc[ai][bj][m][n][j];
      }
      __syncthreads();
      const int r0 = brow + ai * 128, c0 = bcol + bj * 128;
      if (IS(EPI_SWIGLU)) {
#pragma unroll
        for (int i = 0; i < 2; ++i) {
          const int item = tid_e + NT * i;
          const int row = item >> 3, o0 = (item & 7) * 8;
          const int gc = (o0 >> 4) * 32 + (o0 & 15);
          const float* sp = stg + row * STG_LD + gc;
          float4 g0 = *(const float4*)(sp), g1 = *(const float4*)(sp + 4);
          float4 u0 = *(const float4*)(sp + 16), u1 = *(const float4*)(sp + 20);
          float o[8] = {siluf_(g0.x) * u0.x, siluf_(g0.y) * u0.y, siluf_(g0.z) * u0.z, siluf_(g0.w) * u0.w,
                        siluf_(g1.x) * u1.x, siluf_(g1.y) * u1.y, siluf_(g1.z) * u1.z, siluf_(g1.w) * u1.w};
          *(uint4*)(e.o16 + (size_t)(r0 + row) * FF + (c0 >> 1) + o0) = pack8(o);
        }
      } else if (IS(EPI_VT)) {
#pragma unroll 1
        for (int i = 0; i < 4; ++i) {
          const int item = tid_e + NT * i;
          const int kg = item & 15, dl = item >> 4;
          const float* sp = stg + dl * STG_LD + kg * 8;
          float4 a = *(const float4*)sp, b4 = *(const float4*)(sp + 4);
          float o[8] = {a.x, a.y, a.z, a.w, b4.x, b4.y, b4.z, b4.w};
          const int tok = r0 + kg * 8;
          const int b = tok >> 13, t = tok & (TT - 1), nblk = t >> 8, key = t & 255;
          const int col = c0 + dl, h = col >> 6, d = col & 63;
          *(uint4*)(e.o16 + ((size_t)(((b * 16 + h) * 32 + nblk) * 64 + d)) * 256 + key) = pack8(o);
        }
      } else {
#pragma unroll 1
        for (int i = 0; i < 4; ++i) {
          const int row = (tid_e >> 4) + 32 * i, cg = tid_e & 15;
          const float* sp = stg + row * STG_LD + cg * 8;
          float4 a = *(const float4*)sp, b4 = *(const float4*)(sp + 4);
          float v[8] = {a.x, a.y, a.z, a.w, b4.x, b4.y, b4.z, b4.w};
          const int grow = r0 + row, gcol = c0 + cg * 8;
          if (IS(EPI_BF16) || IS(EPI_TANH) || IS(EPI_SIG)) {
#pragma unroll
            for (int q = 0; q < 8; ++q) {
              if (IS(EPI_TANH)) v[q] = tanhf_(v[q]);
              if (IS(EPI_SIG)) v[q] = sigmoidf_(v[q]);
            }
            *(uint4*)(e.o16 + (size_t)grow * e.ldo + gcol) = pack8(v);
          } else if (IS(EPI_DECAY)) {
            float4 w0a = *(const float4*)(e.v0 + gcol), w0b = *(const float4*)(e.v0 + gcol + 4);
            float w0[8] = {w0a.x, w0a.y, w0a.z, w0a.w, w0b.x, w0b.y, w0b.z, w0b.w};
            float o[8];
#pragma unroll
            for (int q = 0; q < 8; ++q) {
              o[q] = __expf(-0.60653066f * sigmoidf_(w0[q] + v[q]));
            }
            float* op = e.o32 + (size_t)grow * DM + gcol;
            *(float4*)op = make_float4(o[0], o[1], o[2], o[3]);
            *(float4*)(op + 4) = make_float4(o[4], o[5], o[6], o[7]);
          } else if (IS(EPI_AK)) {
            const size_t off = (size_t)grow * DM + gcol;
            float kv[8]; unpack8(*(const uint4*)(e.kbuf + off), kv);
            float4 t0 = *(const float4*)(e.v0 + gcol), t1 = *(const float4*)(e.v0 + gcol + 4);
            float a0[8] = {t0.x, t0.y, t0.z, t0.w, t1.x, t1.y, t1.z, t1.w};
            t0 = *(const float4*)(e.v1 + gcol); t1 = *(const float4*)(e.v1 + gcol + 4);
            float kkc[8] = {t0.x, t0.y, t0.z, t0.w, t1.x, t1.y, t1.z, t1.w};
            t0 = *(const float4*)(e.v2 + gcol); t1 = *(const float4*)(e.v2 + gcol + 4);
            float kac[8] = {t0.x, t0.y, t0.z, t0.w, t1.x, t1.y, t1.z, t1.w};
            float kkv[8], ss = 0.f;
#pragma unroll
            for (int q = 0; q < 8; ++q) { kkv[q] = kv[q] * kkc[q]; ss += kkv[q] * kkv[q]; }
            ss += __shfl_xor(ss, 1); ss += __shfl_xor(ss, 2); ss += __shfl_xor(ss, 4);
            const float inv = fminf(__builtin_amdgcn_rsqf(ss), 1e12f);
            float o1[8], o2[8], o3[8];
#pragma unroll
            for (int q = 0; q < 8; ++q) {
              const float aa = sigmoidf_(a0[q] + v[q]);
              const float kkn = kkv[q] * inv;
              o1[q] = kv[q] * (1.f + (aa - 1.f) * kac[q]);
              o2[q] = kkn;
              o3[q] = kkn * aa;
            }
            *(uint4*)(e.kbuf + off) = pack8(o1);
            *(uint4*)(e.kkbuf + off) = pack8(o2);
            *(uint4*)(e.abbuf + off) = pack8(o3);
          } else if (IS(EPI_RESID)) {
            const size_t off = (size_t)grow * DM + gcol;
            const float* gp = e.gate + (size_t)(grow >> 13) * MODLD + gcol;
            float4 r0v = *(const float4*)(e.res + off), r1v = *(const float4*)(e.res + off + 4);
            float4 g0 = *(const float4*)gp, g1 = *(const float4*)(gp + 4);
            *(float4*)(e.o32 + off) = make_float4(r0v.x + g0.x * v[0], r0v.y + g0.y * v[1], r0v.z + g0.z * v[2], r0v.w + g0.w * v[3]);
            *(float4*)(e.o32 + off + 4) = make_float4(r1v.x + g1.x * v[4], r1v.y + g1.y * v[5], r1v.z + g1.z * v[6], r1v.w + g1.w * v[7]);
          } else if (IS(EPI_HEADNORM)) {
            float ss = 0.f;
#pragma unroll
            for (int q = 0; q < 8; ++q) ss += v[q] * v[q];
            ss += __shfl_xor(ss, 1); ss += __shfl_xor(ss, 2); ss += __shfl_xor(ss, 4);
            const float rs = rsqrtf(ss * (1.f / 64.f) + 1e-6f);
            float4 t0 = *(const float4*)(e.v0 + (gcol & 63)), t1 = *(const float4*)(e.v0 + (gcol & 63) + 4);
            float gn[8] = {t0.x, t0.y, t0.z, t0.w, t1.x, t1.y, t1.z, t1.w};
#pragma unroll
            for (int q = 0; q < 8; ++q) v[q] = v[q] * rs * gn[q];
            *(uint4*)(e.o16 + (size_t)grow * DM + gcol) = pack8(v);
          }
        }
      }
    }
}

__device__ __forceinline__ int tile_remap(int i) {
  const int G = gridDim.x;
  const int b = i % G, r = i / G;
  const int per = G >> 3;
  return r * G + (b & 7) * per + (b >> 3);
}

typedef float v2f __attribute__((ext_vector_type(2)));
constexpr int SC_TC = 16;
constexpr int SC_BUF = 5 * SC_TC * 64 * 4 + SC_TC * 16 * 4;
struct ScanRegs { uint4 a, b; float4 d; uint2 v; };

__device__ __forceinline__ void phase_scan(const Params& p, unsigned char* smem) {
  if (blockIdx.x >= 256) return;
  const int sb = blockIdx.x, bh = sb & 63, rg = sb >> 6;
  const int b = bh >> 4, h = bh & 15;
  const size_t base = (size_t)b * TT * DM + h * 64;
  const u16* Rb = (const u16*)(p.ws + SLOT(6));
  const u16* Kb = (const u16*)DSLOT(p, 0);
  const u16* Vb = (const u16*)DSLOT(p, 1);
  const u16* KKb = (const u16*)(p.ws + SLOT(3));
  const u16* ABb = (const u16*)(p.ws + SLOT(4));
  const float* DECb = (const float*)(p.ws + SLOT(1));
  u16* Yb = (u16*)(p.ws + SLOT(0));
  if (threadIdx.x >= 256) {
    const int tid = threadIdx.x - 256;
    const int ls = (tid & 127) >> 3, lc8 = tid & 7, pair = tid >> 7;
    const u16* pa = (pair ? KKb : Rb) + base + (size_t)ls * DM + lc8 * 8;
    const u16* pb = (pair ? ABb : Kb) + base + (size_t)ls * DM + lc8 * 8;
    const float* pd = DECb + base + (size_t)(tid >> 4) * DM + (tid & 15) * 4;
    const u16* pv = Vb + base + (size_t)((tid & 63) >> 2) * DM + rg * 16 + (tid & 3) * 4;
    auto gload = [&](ScanRegs& R, int t0) {
      const size_t o = (size_t)t0 * DM;
      R.a = *(const uint4*)(pa + o);
      R.b = *(const uint4*)(pb + o);
      R.d = *(const float4*)(pd + o);
      R.v = *(const uint2*)(pv + o);
    };
    auto lstore = [&](const ScanRegs& R, int buf) {
      float* L = (float*)(smem + buf * SC_BUF);
      float* la = L + (pair ? 2 : 0) * (SC_TC * 64) + ls * 64 + lc8 * 8;
      float* lb = L + (pair ? 3 : 1) * (SC_TC * 64) + ls * 64 + lc8 * 8;
      const float sg = pair ? -1.f : 1.f;
      *(float4*)(la) = make_float4(sg * bflo(R.a.x), sg * bfhi(R.a.x), sg * bflo(R.a.y), sg * bfhi(R.a.y));
      *(float4*)(la + 4) = make_float4(sg * bflo(R.a.z), sg * bfhi(R.a.z), sg * bflo(R.a.w), sg * bfhi(R.a.w));
      *(float4*)(lb) = make_float4(bflo(R.b.x), bfhi(R.b.x), bflo(R.b.y), bfhi(R.b.y));
      *(float4*)(lb + 4) = make_float4(bflo(R.b.z), bfhi(R.b.z), bflo(R.b.w), bfhi(R.b.w));
      *(float4*)(L + 4 * (SC_TC * 64) + (tid >> 4) * 64 + (tid & 15) * 4) = R.d;
      if (tid < 64) *(float4*)(L + 5 * (SC_TC * 64) + (tid >> 2) * 16 + (tid & 3) * 4) = make_float4(bflo(R.v.x), bfhi(R.v.x), bflo(R.v.y), bfhi(R.v.y));
    };
    ScanRegs X, Y;
    gload(X, 0);
    lstore(X, 0);
    gload(X, SC_TC);
    gload(Y, 2 * SC_TC);
    __syncthreads();
#pragma unroll 1
    for (int t0 = 0; t0 < TT; t0 += 2 * SC_TC) {
      lstore(X, 1);
      gload(X, min(t0 + 3 * SC_TC, TT - SC_TC));
      __syncthreads();
      lstore(Y, 0);
      gload(Y, min(t0 + 4 * SC_TC, TT - SC_TC));
      __syncthreads();
    }
  } else {
    const int tid = threadIdx.x, w = tid >> 6, lane = tid & 63;
    const int rl = lane >> 4, cl = lane & 15;
    const int row = rg * 16 + w * 4 + rl;
    u16* yp = Yb + base + row + (size_t)cl * DM;
    float S0 = 0.f, S1 = 0.f, S2 = 0.f, S3 = 0.f;
    struct StepIn { float4 r4, k4, n4, b4, d4; float v; };
    auto ldsload = [&](const float* L, int s) {
      StepIn q;
      q.n4 = *(const float4*)(L + 2 * (SC_TC * 64) + s * 64 + cl * 4);
      q.b4 = *(const float4*)(L + 3 * (SC_TC * 64) + s * 64 + cl * 4);
      q.d4 = *(const float4*)(L + 4 * (SC_TC * 64) + s * 64 + cl * 4);
      q.k4 = *(const float4*)(L + 1 * (SC_TC * 64) + s * 64 + cl * 4);
      q.v = L[5 * (SC_TC * 64) + s * 16 + w * 4 + rl];
      q.r4 = *(const float4*)(L + 0 * (SC_TC * 64) + s * 64 + cl * 4);
      return q;
    };
    float rp0 = 0.f, rp1 = 0.f, rp2 = 0.f, rp3 = 0.f;
    float yacc = 0.f;
    auto step = [&](const StepIn& c) -> float {
      float t0, t1, y0, y1, u0, u1, u2, u3;
      asm volatile(
          "v_mul_f32 %0, %8, %12\n\t"
          "v_mul_f32 %2, %8, %16\n\t"
          "v_mul_f32 %1, %10, %14\n\t"
          "v_mul_f32 %3, %10, %18\n\t"
          "v_fmac_f32 %0, %9, %13\n\t"
          "v_fmac_f32 %2, %9, %17\n\t"
          "v_fmac_f32 %1, %11, %15\n\t"
          "v_fmac_f32 %3, %11, %19\n\t"
          "v_add_f32 %0, %0, %1\n\t"
          "v_add_f32 %2, %2, %3\n\t"
          "v_mul_f32 %4, %20, %21\n\t"
          "v_add_f32_dpp %0, %0, %0 quad_perm:[1,0,3,2] row_mask:0xf bank_mask:0xf bound_ctrl:1\n\t"
          "v_add_f32_dpp %2, %2, %2 quad_perm:[1,0,3,2] row_mask:0xf bank_mask:0xf bound_ctrl:1\n\t"
          "v_mul_f32 %5, %20, %22\n\t"
          "v_add_f32_dpp %0, %0, %0 quad_perm:[2,3,0,1] row_mask:0xf bank_mask:0xf bound_ctrl:1\n\t"
          "v_add_f32_dpp %2, %2, %2 quad_perm:[2,3,0,1] row_mask:0xf bank_mask:0xf bound_ctrl:1\n\t"
          "v_mul_f32 %6, %20, %23\n\t"
          "v_add_f32_dpp %0, %0, %0 row_ror:4 row_mask:0xf bank_mask:0xf bound_ctrl:1\n\t"
          "v_add_f32_dpp %2, %2, %2 row_ror:4 row_mask:0xf bank_mask:0xf bound_ctrl:1\n\t"
          "v_mul_f32 %7, %20, %24\n\t"
          "v_add_f32_dpp %0, %0, %0 row_ror:8 row_mask:0xf bank_mask:0xf bound_ctrl:1\n\t"
          "v_add_f32_dpp %2, %2, %2 row_ror:8 row_mask:0xf bank_mask:0xf bound_ctrl:1\n\t"
          : "=&v"(t0), "=&v"(t1), "=&v"(y0), "=&v"(y1), "=&v"(u0), "=&v"(u1), "=&v"(u2), "=&v"(u3)
          : "v"(S0), "v"(S1), "v"(S2), "v"(S3), "v"(c.n4.x), "v"(c.n4.y), "v"(c.n4.z), "v"(c.n4.w),
            "v"(rp0), "v"(rp1), "v"(rp2), "v"(rp3), "v"(c.v), "v"(c.k4.x), "v"(c.k4.y), "v"(c.k4.z), "v"(c.k4.w));
      asm volatile(
          "v_fmac_f32 %4, %8, %9\n\t"
          "v_fmac_f32 %5, %8, %10\n\t"
          "v_fmac_f32 %6, %8, %11\n\t"
          "v_fmac_f32 %7, %8, %12\n\t"
          "v_fma_f32 %0, %0, %13, %4\n\t"
          "v_fma_f32 %1, %1, %14, %5\n\t"
          "v_fma_f32 %2, %2, %15, %6\n\t"
          "v_fma_f32 %3, %3, %16, %7\n\t"
          : "+v"(S0), "+v"(S1), "+v"(S2), "+v"(S3), "+v"(u0), "+v"(u1), "+v"(u2), "+v"(u3)
          : "v"(t0), "v"(c.b4.x), "v"(c.b4.y), "v"(c.b4.z), "v"(c.b4.w), "v"(c.d4.x), "v"(c.d4.y), "v"(c.d4.z), "v"(c.d4.w));
      rp0 = c.r4.x; rp1 = c.r4.y; rp2 = c.r4.z; rp3 = c.r4.w;
      return y0;
    };
    auto compute = [&](int buf, int t0) {
      const float* L = (const float*)(smem + buf * SC_BUF);
      StepIn cur = ldsload(L, 0);
#pragma unroll
      for (int s = 0; s < SC_TC; ++s) {
        StepIn nxt = cur;
        if (s + 1 < SC_TC) nxt = ldsload(L, s + 1);
        const float y = step(cur);
        if (s == 0) {
          yacc = (cl == 15) ? y : yacc;
          if (t0 > 0) yp[(size_t)(t0 - SC_TC) * DM] = f2bf(yacc);
        } else {
          yacc = (cl == s - 1) ? y : yacc;
        }
        cur = nxt;
        if ((s & 3) == 3) __builtin_amdgcn_sched_barrier(0);
      }
    };
    __syncthreads();
#pragma unroll 1
    for (int t0 = 0; t0 < TT; t0 += 2 * SC_TC) {
      compute(0, t0);
      __syncthreads();
      compute(1, t0 + SC_TC);
      __syncthreads();
    }
    {
      float y = (S0 * rp0 + S1 * rp1) + (S2 * rp2 + S3 * rp3);
      y = allreduce16(y);
      yacc = (cl == 15) ? y : yacc;
      yp[(size_t)(TT - SC_TC) * DM] = f2bf(yacc);
    }
  }
}

__device__ __forceinline__ void phase_gn(const Params& p) {
  const u16* R = (const u16*)(p.ws + SLOT(6));
  const u16* Kp = (const u16*)DSLOT(p, 0);
  const u16* V = (const u16*)DSLOT(p, 1);
  const u16* G = (const u16*)(p.ws + SLOT(5));
  u16* Y = (u16*)(p.ws + SLOT(0));
  const float* rk = p.in[17];
  const float* lg = p.in[18];
  const float* lb = p.in[19];
  const size_t nchunks = (size_t)MT * 128;
  const size_t stride = (size_t)gridDim.x * NT;
  for (size_t q = (size_t)blockIdx.x * NT + threadIdx.x; q < nchunks; q += stride) {
    const size_t off = q * 8;
    const int c = (int)(off & (DM - 1));
    float y[8], r[8], k[8], v[8], g[8];
    unpack8(*(const uint4*)(Y + off), y); unpack8(*(const uint4*)(R + off), r); unpack8(*(const uint4*)(Kp + off), k);
    unpack8(*(const uint4*)(V + off), v); unpack8(*(const uint4*)(G + off), g);
    float s = 0.f, rks = 0.f;
#pragma unroll
    for (int i = 0; i < 8; ++i) { s += y[i]; rks += r[i] * k[i] * rk[c + i]; }
    s += __shfl_xor(s, 1); s += __shfl_xor(s, 2); s += __shfl_xor(s, 4);
    rks += __shfl_xor(rks, 1); rks += __shfl_xor(rks, 2); rks += __shfl_xor(rks, 4);
    const float mean = s * (1.f / 64.f);
    float vs = 0.f;
#pragma unroll
    for (int i = 0; i < 8; ++i) { float d = y[i] - mean; vs += d * d; }
    vs += __shfl_xor(vs, 1); vs += __shfl_xor(vs, 2); vs += __shfl_xor(vs, 4);
    const float rstd = rsqrtf(vs * (1.f / 64.f) + 64e-5f);
    float z[8];
#pragma unroll
    for (int i = 0; i < 8; ++i) z[i] = ((y[i] - mean) * rstd * lg[c + i] + lb[c + i] + rks * v[i]) * g[i];
    *(uint4*)(Y + off) = pack8(z);
  }
}

__device__ __forceinline__ void phase_kmean(const Params& p) {
  const u16* Kb = (const u16*)(p.ws + SLOT(1));
  float* km = (float*)(p.ws + OFF_KMEAN);
  const int lane = threadIdx.x & 63;
  const int gw = blockIdx.x * NWV + (threadIdx.x >> 6), nw = gridDim.x * NWV;
  for (int it = gw; it < 2048; it += nw) {
    const int bh = it >> 5, n = it & 31, b = bh >> 4, h = bh & 15;
    const u16* kp = Kb + ((size_t)b * TT + n * 256 + (lane >> 3)) * DM + h * 64 + (lane & 7) * 8;
    float s[8] = {0.f, 0.f, 0.f, 0.f, 0.f, 0.f, 0.f, 0.f};
#pragma unroll 8
    for (int j = 0; j < 32; ++j) {
      float f[8]; unpack8(*(const uint4*)(kp + (size_t)j * 8 * DM), f);
#pragma unroll
      for (int q = 0; q < 8; ++q) s[q] += f[q];
    }
#pragma unroll
    for (int q = 0; q < 8; ++q) { s[q] += __shfl_xor(s[q], 8); s[q] += __shfl_xor(s[q], 16); s[q] += __shfl_xor(s[q], 32); }
    if (lane < 8) {
      float* o = km + (size_t)it * 64 + lane * 8;
      *(float4*)o = make_float4(s[0] * (1.f / 256.f), s[1] * (1.f / 256.f), s[2] * (1.f / 256.f), s[3] * (1.f / 256.f));
      *(float4*)(o + 4) = make_float4(s[4] * (1.f / 256.f), s[5] * (1.f / 256.f), s[6] * (1.f / 256.f), s[7] * (1.f / 256.f));
    }
  }
}

__device__ __forceinline__ void phase_gate(const Params& p) {
  const u16* Q = (const u16*)(p.ws + SLOT(4));
  const float* km = (const float*)(p.ws + OFF_KMEAN);
  int* cnt = (int*)(p.ws + OFF_CNT);
  u16* lists = (u16*)(p.ws + SLOT(5));
  float* lse = (float*)(p.ws + OFF_LSE);
  const int lane = threadIdx.x & 63;
  const int gw = blockIdx.x * NWV + (threadIdx.x >> 6), nw = gridDim.x * NWV;
  for (int it0 = gw; it0 < 8192; it0 += nw) {
    const int it = __builtin_amdgcn_readfirstlane(it0);
    const int bh = it >> 7, qg = it & 127, b = bh >> 4, h = bh & 15;
    const int blk = qg >> 2;
    const int t = qg * 64 + lane;
    const size_t m = (size_t)b * TT + t;
    float q[64];
    {
      const uint4* qp = (const uint4*)(Q + m * DM + h * 64);
#pragma unroll
      for (int i = 0; i < 8; ++i) unpack8(qp[i], q + 8 * i);
    }
    float s0 = -3e38f, s1 = -3e38f, s2 = -3e38f;
    int i0 = 0, i1 = 0, i2 = 0;
    for (int n = 0; n < blk; ++n) {
      const float* kr = km + ((size_t)bh * 32 + n) * 64;
      float s = 0.f;
#pragma unroll
      for (int d = 0; d < 64; ++d) s += q[d] * kr[d];
      if (s > s0) { s2 = s1; i2 = i1; s1 = s0; i1 = i0; s0 = s; i0 = n; }
      else if (s > s1) { s2 = s1; i2 = i1; s1 = s; i1 = n; }
      else if (s > s2) { s2 = s; i2 = n; }
    }
    const int nsel = min(3, blk);
    unsigned long long mymask = 0ull;
    for (int n = 0; n < blk; ++n) {
      const bool sel = (i0 == n) || (nsel > 1 && i1 == n) || (nsel > 2 && i2 == n);
      const unsigned long long mk = __ballot(sel);
      if (lane == n) mymask = mk;
    }
    const int tot = __popcll(mymask);
    int base = 0;
    if (lane < blk && tot > 0) base = atomicAdd(&cnt[bh * 32 + lane], tot);
    const unsigned mlo = (unsigned)mymask, mhi = (unsigned)(mymask >> 32);
    const unsigned long long below = (1ull << lane) - 1ull;
#pragma unroll
    for (int s = 0; s < 3; ++s) {
      const int n = (s == 0) ? i0 : (s == 1) ? i1 : i2;
      const unsigned lo = __shfl(mlo, n), hi = __shfl(mhi, n);
      const int bs = __shfl(base, n);
      if (s < nsel) {
        const unsigned long long mk = ((unsigned long long)hi << 32) | lo;
        const int pos = bs + __popcll(mk & below);
        lists[(size_t)(bh * 32 + n) * 8192 + pos] = (u16)(t | (s << 13));
      } else {
        lse[(size_t)s * MT * 16 + m * 16 + h] = -1e30f;
      }
    }
  }
}

constexpr int VT_LD = 528;
__device__ __forceinline__ int swz(int row, int chunk) { return row * 128 + ((chunk ^ ((row >> 1) & 7)) << 4); }

template <bool OWN>
__device__ __forceinline__ void attn_tile(const bf16x8 q0, const bf16x8 q1, int tloc, const unsigned char* smem,
                                          float& mout, float& lout, f32x4 O[4]) {
  const int lane = threadIdx.x & 63, g = lane >> 4, c16 = lane & 15;
  f32x4 S[16];
#pragma unroll
  for (int kt = 0; kt < 16; ++kt) {
    const int row = kt * 16 + c16;
    bf16x8 k0 = *(const bf16x8*)(smem + swz(row, g));
    bf16x8 k1 = *(const bf16x8*)(smem + swz(row, g + 4));
    f32x4 z = (f32x4){0.f, 0.f, 0.f, 0.f};
    z = __builtin_amdgcn_mfma_f32_16x16x32_bf16(k0, q0, z, 0, 0, 0);
    z = __builtin_amdgcn_mfma_f32_16x16x32_bf16(k1, q1, z, 0, 0, 0);
    S[kt] = z;
    if ((kt & 3) == 3) __builtin_amdgcn_sched_barrier(0);
  }
  float mx = -3e38f;
#pragma unroll
  for (int kt = 0; kt < 16; ++kt)
#pragma unroll
    for (int r = 0; r < 4; ++r) {
      float s = S[kt][r] * (0.125f * 1.44269504f);
      if (OWN) { if (kt * 16 + 4 * g + r > tloc) s = -3e38f; }
      S[kt][r] = s;
      mx = fmaxf(mx, s);
    }
  mx = fmaxf(mx, __shfl_xor(mx, 16));
  mx = fmaxf(mx, __shfl_xor(mx, 32));
  float l = 0.f;
#pragma unroll
  for (int kt = 0; kt < 16; ++kt)
#pragma unroll
    for (int r = 0; r < 4; ++r) {
      float pv = __builtin_amdgcn_exp2f(S[kt][r] - mx);
      S[kt][r] = pv;
      l += pv;
    }
  l += __shfl_xor(l, 16);
  l += __shfl_xor(l, 32);
#pragma unroll
  for (int dt = 0; dt < 4; ++dt) O[dt] = (f32x4){0.f, 0.f, 0.f, 0.f};
  const unsigned char* vb = smem + 32768;
#pragma unroll
  for (int j = 0; j < 8; ++j) {
    union { bf16x8 v; unsigned u[4]; } pf;
    pf.u[0] = pack2(S[2 * j][0], S[2 * j][1]);
    pf.u[1] = pack2(S[2 * j][2], S[2 * j][3]);
    pf.u[2] = pack2(S[2 * j + 1][0], S[2 * j + 1][1]);
    pf.u[3] = pack2(S[2 * j + 1][2], S[2 * j + 1][3]);
#pragma unroll
    for (int dt = 0; dt < 4; ++dt) {
      const unsigned char* vp = vb + (dt * 16 + c16) * VT_LD + (32 * j + 4 * g) * 2;
      union { bf16x8 v; uint2 h[2]; } vf;
      vf.h[0] = *(const uint2*)(vp);
      vf.h[1] = *(const uint2*)(vp + 32);
      O[dt] = __builtin_amdgcn_mfma_f32_16x16x32_bf16(vf.v, pf.v, O[dt], 0, 0, 0);
    }
    if (j & 1) __builtin_amdgcn_sched_barrier(0);
  }
  mout = mx * 0.69314718f; lout = l;
}

__device__ __forceinline__ u16* part_ptr(const Params& p, int slot) {
  return (u16*)(p.ws + (slot == 0 ? SLOT(0) : slot == 1 ? SLOT(3) : SLOT(6)));
}

struct AItem { int li, seg, b, h, n, c; };

template <bool OWN>
__device__ __forceinline__ void phase_attn(const Params& p, unsigned char* smem) {
  const int tid = threadIdx.x, lane = tid & 63, w = tid >> 6, g = lane >> 4, c16 = lane & 15;
  const int G = gridDim.x;
  const int* cnt = (const int*)(p.ws + OFF_CNT);
  const u16* lists = (const u16*)(p.ws + SLOT(5));
  u16* Q = (u16*)(p.ws + SLOT(4));
  float* lse = (float*)(p.ws + OFF_LSE);
  int* offs = (int*)(smem + 66560);
  unsigned char* Qs = smem + 75008;
  unsigned* entl = (unsigned*)(smem + 75008 + 16384);
  int total = 4096;
  if (!OWN) {
    int* part = (int*)smem;
    int loc[4]; int s = 0;
#pragma unroll
    for (int i = 0; i < 4; ++i) { loc[i] = (cnt[tid * 4 + i] + 127) >> 7; s += loc[i]; }
    part[tid] = s;
    __syncthreads();
    if (tid == 0) { int a = 0; for (int i = 0; i < NT; ++i) { int v = part[i]; part[i] = a; a += v; } offs[2048] = a; }
    __syncthreads();
    int a = part[tid];
#pragma unroll
    for (int i = 0; i < 4; ++i) { offs[tid * 4 + i] = a; a += loc[i]; }
    __syncthreads();
    total = offs[2048];
  }
  if ((int)blockIdx.x >= total) return;
  const int J = (total - 1 - (int)blockIdx.x) / G + 1;
  int* itab = (int*)(smem + 75008 + 16384 + 512);
  int* ctab = itab + 1024;
  if (!OWN) {
    for (int j = tid; j < J; j += NT) {
      const int it_ = blockIdx.x + j * G;
      int lo = 0, hi = 2048;
      while (hi - lo > 1) { int mid = (lo + hi) >> 1; if (offs[mid] <= it_) lo = mid; else hi = mid; }
      itab[j] = lo | ((it_ - offs[lo]) << 11);
      ctab[j] = cnt[lo];
    }
    __syncthreads();
  }

  auto decode = [&](int j) {
    AItem d;
    if (OWN) { const int it = blockIdx.x + j * G; d.li = it >> 1; d.seg = it & 1; d.c = 0; }
    else {
      const int pk = itab[j];
      d.li = pk & 2047; d.seg = pk >> 11; d.c = ctab[j];
    }
    const int bh = d.li >> 5;
    d.n = d.li & 31; d.b = bh >> 4; d.h = bh & 15;
    return d;
  };
  auto load_ent1 = [&](const AItem& d, const int i) -> unsigned {
    const int row = (tid >> 3) + 64 * i;
    if (OWN) return (unsigned)(d.n * 256 + d.seg * 128 + row) | 0x8000u;
    const int qi = d.seg * 128 + row;
    const int qc = min(qi, 8191);
    unsigned v = lists[(size_t)d.li * 8192 + qc];
    return (qi < d.c) ? (v | 0x8000u) : 0u;
  };
  uint4 kr0, kr1, kr2, kr3, vr0, vr1, vr2, vr3, qr0, qr1;
  auto load_kvq = [&](const AItem& d, const unsigned e0, const unsigned e1) {
    const u16* Kb = (const u16*)(p.ws + SLOT(1)) + ((size_t)d.b * TT + d.n * 256) * DM + d.h * 64;
    const u16* Vt = (const u16*)(p.ws + SLOT(2)) + (size_t)(((d.b * 16 + d.h) * 32 + d.n) * 64) * 256;
#define LDKV(i, K_, V_) { const int idx = tid + NT * (i); K_ = *(const uint4*)(Kb + (size_t)(idx >> 3) * DM + (idx & 7) * 8); V_ = *(const uint4*)(Vt + (size_t)idx * 8); }
    LDKV(0, kr0, vr0) LDKV(1, kr1, vr1) LDKV(2, kr2, vr2) LDKV(3, kr3, vr3)
#undef LDKV
    qr0 = *(const uint4*)(Q + ((size_t)d.b * TT + (e0 & 8191u)) * DM + d.h * 64 + (tid & 7) * 8);
    qr1 = *(const uint4*)(Q + ((size_t)d.b * TT + (e1 & 8191u)) * DM + d.h * 64 + (tid & 7) * 8);
  };
  auto store_lds = [&](const unsigned e0, const unsigned e1) {
#define STKV(i, K_, V_) { const int idx = tid + NT * (i); *(uint4*)(smem + swz(idx >> 3, idx & 7)) = K_; *(uint4*)(smem + 32768 + (idx >> 5) * VT_LD + (idx & 31) * 16) = V_; }
    STKV(0, kr0, vr0) STKV(1, kr1, vr1) STKV(2, kr2, vr2) STKV(3, kr3, vr3)
#undef STKV
    *(uint4*)(Qs + swz(tid >> 3, tid & 7)) = qr0;
    *(uint4*)(Qs + swz((tid >> 3) + 64, tid & 7)) = qr1;
    if ((tid & 7) == 0) { entl[tid >> 3] = e0; entl[(tid >> 3) + 64] = e1; }
  };

  int it = 0;
  AItem dc = decode(0);
  unsigned ec0 = load_ent1(dc, 0), ec1 = load_ent1(dc, 1);
  load_kvq(dc, ec0, ec1);
  int itn = min(1, J - 1);
  AItem dn = decode(itn);
  unsigned en0 = load_ent1(dn, 0), en1 = load_ent1(dn, 1);
  while (true) {
    __syncthreads();
    store_lds(ec0, ec1);
    __syncthreads();
    load_kvq(dn, en0, en1);
    ec0 = en0; ec1 = en1;
    const AItem d = dc;
    dc = dn;
    itn = min(itn + 1, J - 1);
    dn = decode(itn);
    en0 = load_ent1(dn, 0); en1 = load_ent1(dn, 1);
    {
      const int row = w * 16 + c16;
      const unsigned ent = entl[row];
      const bool valid = (ent >> 15) != 0;
      const int t = ent & 8191, slot = (ent >> 13) & 3;
      const size_t m = (size_t)d.b * TT + t;
      const bf16x8 q0 = *(const bf16x8*)(Qs + swz(row, g));
      const bf16x8 q1 = *(const bf16x8*)(Qs + swz(row, g + 4));
      float mx, l; f32x4 O[4];
      attn_tile<OWN>(q0, q1, d.seg * 128 + row, smem, mx, l, O);
      if (!OWN) {
        if (valid) {
          const float inv = frcp_(l);
          u16* po = part_ptr(p, slot) + m * DM + d.h * 64;
#pragma unroll
          for (int dt = 0; dt < 4; ++dt) {
            uint2 o;
            o.x = pack2(O[dt][0] * inv, O[dt][1] * inv);
            o.y = pack2(O[dt][2] * inv, O[dt][3] * inv);
            *(uint2*)(po + dt * 16 + 4 * g) = o;
          }
          if (g == 0) lse[(size_t)slot * MT * 16 + m * 16 + d.h] = mx + __logf(l);
        }
      } else {
        float ls[3], M2 = mx;
#pragma unroll
        for (int s = 0; s < 3; ++s) { ls[s] = lse[(size_t)s * MT * 16 + m * 16 + d.h]; M2 = fmaxf(M2, ls[s]); }
        const float wo = __expf(mx - M2);
        float ws[3], den = l * wo;
#pragma unroll
        for (int s = 0; s < 3; ++s) { ws[s] = (ls[s] > -1e29f) ? __expf(ls[s] - M2) : 0.f; den += ws[s]; }
        const float inv = frcp_(den);
#pragma unroll
        for (int dt = 0; dt < 4; ++dt) {
          float o0 = O[dt][0] * wo, o1 = O[dt][1] * wo, o2 = O[dt][2] * wo, o3 = O[dt][3] * wo;
#pragma unroll
          for (int s = 0; s < 3; ++s) {
            if (ws[s] != 0.f) {
              const u16* pp = part_ptr(p, s) + m * DM + d.h * 64 + dt * 16 + 4 * g;
              uint2 u = *(const uint2*)pp;
              o0 += ws[s] * bflo(u.x); o1 += ws[s] * bfhi(u.x); o2 += ws[s] * bflo(u.y); o3 += ws[s] * bfhi(u.y);
            }
          }
          uint2 o;
          o.x = pack2(o0 * inv, o1 * inv);
          o.y = pack2(o2 * inv, o3 * inv);
          *(uint2*)(Q + m * DM + d.h * 64 + dt * 16 + 4 * g) = o;
        }
      }
    }
    it += 1;
    if (it >= J) break;
  }
}

#define TILE_LOOP(total) for (int _i = blockIdx.x, _G = gridDim.x, _tot = (total), _end = ((_tot + _G - 1) / _G) * _G; _i < _end; _i += _G)

#define EB(x) (1 << (x))
__device__ __forceinline__ void phase_rkv(const Params& p, unsigned char* smem) {
  const u16* wt = (const u16*)p.ws;
  TILE_LOOP(1536) {
    const int tile = tile_remap(_i);
    if (tile >= 1536) continue;
    const int s = tile >> 9, rem = tile & 511, mt = rem >> 2, nt = rem & 3;
    Epi e{};
    e.o16 = (s == 0) ? (u16*)(p.ws + SLOT(6)) : (u16*)DSLOT(p, s - 1); e.ldo = DM;
    gemm_tile<EB(EPI_BF16)>((const u16*)(p.ws + SLOT(s)), wt + WT_RKV + (size_t)s * M1, DM, mt * 256, nt * 256, EPI_BF16, e, smem);
  }
}

__device__ __forceinline__ void phase_lora1(const Params& p, unsigned char* smem) {
  const u16* wt = (const u16*)p.ws;
  u16* lora = (u16*)(p.ws + SLOT(0));
  TILE_LOOP(384) {
    const int tile = _i;
    if (tile >= 384) continue;
    const int j = tile >> 7, mt = tile & 127;
    Epi e{};
    e.o16 = lora + (size_t)j * MT * 256; e.ldo = 256;
    const u16* A = (const u16*)(p.ws + SLOT(3 + j));
    const u16* B = wt + WT_W1 + (size_t)j * 256 * 1024;
    const int epi = (j == 0) ? EPI_TANH : (j == 1) ? EPI_BF16 : EPI_SIG;
    gemm_tile<EB(EPI_TANH) | EB(EPI_BF16) | EB(EPI_SIG)>(A, B, DM, mt * 256, 0, epi, e, smem);
  }
}

__device__ __forceinline__ void phase_lora2(const Params& p, unsigned char* smem) {
  const u16* wt = (const u16*)p.ws;
  const u16* lora = (const u16*)(p.ws + SLOT(0));
  TILE_LOOP(1536) {
    const int tile = tile_remap(_i);
    if (tile >= 1536) continue;
    const int which = tile >> 9, rem = tile & 511, mt = rem >> 2, nt = rem & 3;
    Epi e{};
    e.o32 = (float*)(p.ws + SLOT(1));
    e.v0 = (which == 0) ? p.in[7] : p.in[10]; e.v1 = p.in[15]; e.v2 = p.in[16];
    e.kbuf = (u16*)DSLOT(p, 0); e.kkbuf = (u16*)(p.ws + SLOT(3)); e.abbuf = (u16*)(p.ws + SLOT(4));
    e.o16 = (u16*)(p.ws + SLOT(5)); e.ldo = DM;
    const int epi = (which == 0) ? EPI_DECAY : (which == 1) ? EPI_AK : EPI_BF16;
    gemm_tile<EB(EPI_DECAY) | EB(EPI_AK) | EB(EPI_BF16)>(lora + (size_t)which * MT * 256, wt + WT_W2 + (size_t)which * 256 * 1024, 256,
                                                        mt * 256, nt * 256, epi, e, smem);
  }
}

__device__ __forceinline__ void phase_resid(const Params& p, const u16* A, int K, const u16* Bt, const float* res, float* out, int gate_off, unsigned char* smem) {
  const float* mod = (const float*)(p.ws + OFF_MOD);
  TILE_LOOP(512) {
    const int tile = tile_remap(_i);
    if (tile >= 512) continue;
    const int mt = tile >> 2, nt = tile & 3;
    Epi e{};
    e.o32 = out; e.res = res; e.gate = mod + gate_off;
    gemm_tile<EB(EPI_RESID)>(A, Bt, K, mt * 256, nt * 256, EPI_RESID, e, smem);
  }
}

__device__ __forceinline__ void phase_ffn_up(const Params& p, const u16* A, const u16* Bt, u16* act, unsigned char* smem) {
  TILE_LOOP(128 * 22) {
    const int tile = tile_remap(_i);
    if (tile >= 128 * 22) continue;
    const int st = tile >> 5, w = tile & 31;
    int mt2, nt2;
    if (st < 80) { mt2 = (st / 5) * 8 + (w >> 2); nt2 = (st % 5) * 4 + (w & 3); }
    else { mt2 = (st - 80) * 16 + (w >> 1); nt2 = 20 + (w & 1); }
    Epi e{};
    e.o16 = act;
    gemm_tile<EB(EPI_SWIGLU)>(A, Bt, DM, mt2 * 256, nt2 * 256, EPI_SWIGLU, e, smem);
  }
}

__device__ __forceinline__ void phase_qkv(const Params& p, unsigned char* smem) {
  const u16* wt = (const u16*)p.ws;
  TILE_LOOP(1536) {
    const int tile = tile_remap(_i);
    if (tile >= 1536) continue;
    const int which = tile >> 9, rem = tile & 511, mt = rem >> 2, nt = rem & 3;
    Epi e{};
    e.o16 = (u16*)(p.ws + (which == 0 ? SLOT(1) : which == 1 ? SLOT(2) : SLOT(4)));
    e.v0 = (which == 0) ? p.in[29] : p.in[31];
    const u16* A = (const u16*)(p.ws + (which == 2 ? SLOT(3) : SLOT(0)));
    const u16* B = wt + WT_KVK + (size_t)which * M1;
    const int epi = (which == 1) ? EPI_VT : EPI_HEADNORM;
    gemm_tile<EB(EPI_HEADNORM) | EB(EPI_VT)>(A, B, DM, mt * 256, nt * 256, epi, e, smem);
  }
}

constexpr int NPHASES = 21;
#ifdef ONLY_PHASE
#define PEN(k) ((k) == ONLY_PHASE)
#else
#define PEN(k) true
#endif
#define RUN(k, call) if (ph0 <= (k) && (k) < ph1) { if (PEN(k)) { call; } if ((k) + 1 < ph1) grid.sync(); }

__global__ void __launch_bounds__(512, 2) mega(Params p, int ph0, int ph1) {
  __shared__ __attribute__((aligned(16))) unsigned char smem[SMEM_BYTES];
  cg::grid_group grid = cg::this_grid();
  const float* mod = (const float*)(p.ws + OFF_MOD);
  const u16* wt = (const u16*)p.ws;
  RUN(0, phase_prep(p, smem))
  RUN(1, phase_norm_xs(p))
  RUN(2, phase_rkv(p, smem))
  RUN(3, phase_lora1(p, smem))
  RUN(4, phase_lora2(p, smem))
  RUN(5, phase_scan(p, smem))
  RUN(6, phase_gn(p))
  RUN(7, phase_resid(p, (const u16*)(p.ws + SLOT(0)), DM, wt + WT_WO, p.in[0], (float*)(p.ws + SLOT(1)), 2048, smem))
  RUN(8, phase_norm((const float*)(p.ws + SLOT(1)), p.in[2] + 1024, mod, 3072, 3072 + 1024, (u16*)(p.ws + SLOT(3)), nullptr, 0, 0, nullptr))
  RUN(9, phase_ffn_up(p, (const u16*)(p.ws + SLOT(3)), wt + WT_GU, (u16*)(p.ws + SLOT(4)), smem))
  RUN(10, phase_resid(p, (const u16*)(p.ws + SLOT(4)), FF, wt + WT_DN, (const float*)(p.ws + SLOT(1)), p.out, 3072 + 2048, smem))
  RUN(11, phase_norm(p.out, p.in[24], mod, 12288, 12288 + 1024, (u16*)(p.ws + SLOT(0)), p.in[2] + 2048, 6144, 6144 + 1024, (u16*)(p.ws + SLOT(3))))
  RUN(12, phase_qkv(p, smem))
  RUN(13, phase_kmean(p))
  RUN(14, phase_gate(p))
  RUN(15, phase_attn<false>(p, smem))
  RUN(16, phase_attn<true>(p, smem))
  RUN(17, phase_resid(p, (const u16*)(p.ws + SLOT(4)), DM, wt + WT_MBO, p.out, p.out, 6144 + 2048, smem))
  RUN(18, phase_norm(p.out, p.in[2] + 3072, mod, 9216, 9216 + 1024, (u16*)(p.ws + SLOT(0)), nullptr, 0, 0, nullptr))
  RUN(19, phase_ffn_up(p, (const u16*)(p.ws + SLOT(0)), wt + WT_GU + (size_t)5632 * 1024, (u16*)(p.ws + SLOT(1)), smem))
  RUN(20, phase_resid(p, (const u16*)(p.ws + SLOT(1)), FF, wt + WT_DN + (size_t)1024 * 2816, p.out, p.out, 9216 + 2048, smem))
}

extern "C" void kernel_launch(void* const* d_in, const int* in_sizes, int n_in, void* d_out, int out_size,
                              void* d_ws, size_t ws_size, hipStream_t stream) {
  static int grid_blocks = 0;
  if (!grid_blocks) {
    int dev = 0, cus = 0, per_cu = 0;
    (void)hipGetDevice(&dev);
    (void)hipDeviceGetAttribute(&cus, hipDeviceAttributeMultiprocessorCount, dev);
    (void)hipOccupancyMaxActiveBlocksPerMultiprocessor(&per_cu, mega, NT, 0);
    if (per_cu < 1) per_cu = 1;
    grid_blocks = cus;
    if (grid_blocks > cus * per_cu) grid_blocks = cus * per_cu;
    grid_blocks &= ~7;
  }
  Params p{};
  for (int i = 0; i < 33; ++i) p.in[i] = (const float*)d_in[i];
  p.out = (float*)d_out;
  p.ws = (unsigned char*)d_ws;
#if SINGLE_LAUNCH
  int ph0 = 0, ph1 = NPHASES;
  void* args[] = {&p, &ph0, &ph1};
  hipError_t e = hipLaunchCooperativeKernel((void*)mega, dim3(grid_blocks), dim3(NT), args, 0, stream);
  if (e != hipSuccess) fprintf(stderr, "cooperative launch failed: %s (grid %d)\n", hipGetErrorString(e), grid_blocks);
#else
  for (int ph = 0; ph < NPHASES; ++ph) mega<<<grid_blocks, NT, 0, stream>>>(p, ph, ph + 1);
#endif
}
```

```cpp
#include <hip/hip_runtime.h>
#include <hip/hip_cooperative_groups.h>
#include <cstdio>
namespace cg = cooperative_groups;

typedef unsigned short u16;
typedef __attribute__((ext_vector_type(8))) short bf16x8;
typedef __attribute__((ext_vector_type(4))) float f32x4;

#ifndef SINGLE_LAUNCH
#define SINGLE_LAUNCH 1
#endif

constexpr int NT = 512;
constexpr int NWV = 8;
constexpr int DM = 1024, NB = 4, TT = 8192, MT = NB * TT, FF = 2816, NH = 16;
constexpr int MODLD = 14336;
constexpr size_t MiB = 1u << 20;
constexpr size_t M1 = 1048576;

constexpr size_t WT_RKV = 0;
constexpr size_t WT_W1 = WT_RKV + 3 * M1;
constexpr size_t WT_A1 = WT_W1 + 256 * 1024;
constexpr size_t WT_G1 = WT_A1 + 256 * 1024;
constexpr size_t WT_W2 = WT_G1 + 256 * 1024;
constexpr size_t WT_A2 = WT_W2 + 256 * 1024;
constexpr size_t WT_G2 = WT_A2 + 256 * 1024;
constexpr size_t WT_WO = WT_G2 + 256 * 1024;
constexpr size_t WT_GU = WT_WO + M1;
constexpr size_t WT_DN = WT_GU + 2 * 5632 * 1024;
constexpr size_t WT_KVK = WT_DN + 2 * 1024 * 2816;
constexpr size_t WT_KVV = WT_KVK + M1;
constexpr size_t WT_Q = WT_KVV + M1;
constexpr size_t WT_MBO = WT_Q + M1;
constexpr size_t WT_END = WT_MBO + M1;
static_assert(WT_END * 2 <= 52 * MiB, "wt region");
constexpr size_t OFF_MOD = 52 * MiB;
constexpr size_t OFF_CNT = OFF_MOD + 4 * MODLD * 4;
constexpr size_t OFF_KMEAN = OFF_CNT + 2048 * 4;
constexpr size_t OFF_LSE = 53 * MiB;
constexpr size_t OFF_SLOT0 = 64 * MiB;
#define SLOT(i) (OFF_SLOT0 + (size_t)(i) * 64 * MiB)
#define DSLOT(p, i) ((unsigned char*)(p).out + (size_t)(i) * 64 * MiB)

constexpr int STG_LD = 132;
constexpr int STG_BYTES = 128 * STG_LD * 4;
constexpr int SMEM_BYTES = 163840;

struct Params {
  const float* in[33];
  float* out;
  unsigned char* ws;
};

typedef __bf16 bf2v __attribute__((ext_vector_type(2)));
typedef float f2v __attribute__((ext_vector_type(2)));
__device__ __forceinline__ unsigned pack2(float a, float b) {
  f2v f = {a, b};
  bf2v r = __builtin_convertvector(f, bf2v);
  return __builtin_bit_cast(unsigned, r);
}
__device__ __forceinline__ u16 f2bf(float f) { return (u16)(pack2(f, 0.f) & 0xffffu); }
__device__ __forceinline__ float bf2f(u16 h) { return __uint_as_float(((unsigned)h) << 16); }
__device__ __forceinline__ float bflo(unsigned x) { return __uint_as_float(x << 16); }
__device__ __forceinline__ float bfhi(unsigned x) { return __uint_as_float(x & 0xffff0000u); }
__device__ __forceinline__ float frcp_(float x) { return __builtin_amdgcn_rcpf(x); }
__device__ __forceinline__ float sigmoidf_(float x) { return frcp_(1.f + __expf(-x)); }
__device__ __forceinline__ float siluf_(float x) { return x * frcp_(1.f + __expf(-x)); }
__device__ __forceinline__ float tanhf_(float x) { return 1.f - 2.f * frcp_(1.f + __expf(2.f * x)); }

template <int CTRL>
__device__ __forceinline__ float dppf(float x) {
  return __int_as_float(__builtin_amdgcn_update_dpp(0, __float_as_int(x), CTRL, 0xF, 0xF, true));
}
__device__ __forceinline__ float allreduce16(float x) {
  x += dppf<0xB1>(x);
  x += dppf<0x4E>(x);
  x += dppf<0x124>(x);
  x += dppf<0x128>(x);
  return x;
}
__device__ __forceinline__ float wave_sum(float x) {
#pragma unroll
  for (int o = 32; o >= 1; o >>= 1) x += __shfl_xor(x, o);
  return x;
}

__device__ __forceinline__ void unpack8(uint4 u, float* f) {
  f[0] = bflo(u.x); f[1] = bfhi(u.x); f[2] = bflo(u.y); f[3] = bfhi(u.y);
  f[4] = bflo(u.z); f[5] = bfhi(u.z); f[6] = bflo(u.w); f[7] = bfhi(u.w);
}
__device__ __forceinline__ uint4 pack8(const float* f) {
  uint4 o; o.x = pack2(f[0], f[1]); o.y = pack2(f[2], f[3]); o.z = pack2(f[4], f[5]); o.w = pack2(f[6], f[7]); return o;
}

struct TJob { const float* src; u16* dst; int K, N, Kp, Np, mode, which; };

__device__ __forceinline__ TJob get_job(const Params& p, int j) {
  u16* wt = (u16*)p.ws;
  TJob t;
  t.mode = 0; t.which = 0;
  switch (j) {
    case 0: t.src = p.in[6]; t.dst = wt + WT_RKV; t.K = 1024; t.N = 1024; t.Kp = 1024; t.Np = 1024; break;
    case 1: t.src = p.in[6] + M1; t.dst = wt + WT_RKV + M1; t.K = 1024; t.N = 1024; t.Kp = 1024; t.Np = 1024; break;
    case 2: t.src = p.in[6] + 2 * M1; t.dst = wt + WT_RKV + 2 * M1; t.K = 1024; t.N = 1024; t.Kp = 1024; t.Np = 1024; break;
    case 3: t.src = p.in[8]; t.dst = wt + WT_W1; t.K = 1024; t.N = 64; t.Kp = 1024; t.Np = 256; break;
    case 4: t.src = p.in[11]; t.dst = wt + WT_A1; t.K = 1024; t.N = 64; t.Kp = 1024; t.Np = 256; break;
    case 5: t.src = p.in[13]; t.dst = wt + WT_G1; t.K = 1024; t.N = 160; t.Kp = 1024; t.Np = 256; break;
    case 6: t.src = p.in[9]; t.dst = wt + WT_W2; t.K = 64; t.N = 1024; t.Kp = 256; t.Np = 1024; break;
    case 7: t.src = p.in[12]; t.dst = wt + WT_A2; t.K = 64; t.N = 1024; t.Kp = 256; t.Np = 1024; break;
    case 8: t.src = p.in[14]; t.dst = wt + WT_G2; t.K = 160; t.N = 1024; t.Kp = 256; t.Np = 1024; break;
    case 9: t.src = p.in[20]; t.dst = wt + WT_WO; t.K = 1024; t.N = 1024; t.Kp = 1024; t.Np = 1024; break;
    case 10: t.src = p.in[21]; t.dst = wt + WT_GU; t.K = 1024; t.N = 2816; t.Kp = 1024; t.Np = 2816; t.mode = 1; t.which = 0; break;
    case 11: t.src = p.in[22]; t.dst = wt + WT_GU; t.K = 1024; t.N = 2816; t.Kp = 1024; t.Np = 2816; t.mode = 1; t.which = 1; break;
    case 12: t.src = p.in[21] + (size_t)1024 * 2816; t.dst = wt + WT_GU + (size_t)5632 * 1024; t.K = 1024; t.N = 2816; t.Kp = 1024; t.Np = 2816; t.mode = 1; t.which = 0; break;
    case 13: t.src = p.in[22] + (size_t)1024 * 2816; t.dst = wt + WT_GU + (size_t)5632 * 1024; t.K = 1024; t.N = 2816; t.Kp = 1024; t.Np = 2816; t.mode = 1; t.which = 1; break;
    case 14: t.src = p.in[23]; t.dst = wt + WT_DN; t.K = 2816; t.N = 1024; t.Kp = 2816; t.Np = 1024; break;
    case 15: t.src = p.in[23] + (size_t)1024 * 2816; t.dst = wt + WT_DN + (size_t)1024 * 2816; t.K = 2816; t.N = 1024; t.Kp = 2816; t.Np = 1024; break;
    case 16: t.src = p.in[27]; t.dst = wt + WT_KVK; t.K = 1024; t.N = 1024; t.Kp = 1024; t.Np = 1024; break;
    case 17: t.src = p.in[28]; t.dst = wt + WT_KVV; t.K = 1024; t.N = 1024; t.Kp = 1024; t.Np = 1024; break;
    case 18: t.src = p.in[30]; t.dst = wt + WT_Q; t.K = 1024; t.N = 1024; t.Kp = 1024; t.Np = 1024; break;
    default: t.src = p.in[32]; t.dst = wt + WT_MBO; t.K = 1024; t.N = 1024; t.Kp = 1024; t.Np = 1024; break;
  }
  return t;
}
constexpr int NJOBS = 20;

__device__ __forceinline__ void phase_prep(const Params& p, unsigned char* smem) {
  const int tid = threadIdx.x;
  if (blockIdx.x == 0) {
    int* cnt = (int*)(p.ws + OFF_CNT);
    for (int i = tid; i < 2048; i += NT) cnt[i] = 0;
  }
  int total = 0;
  for (int j = 0; j < NJOBS; ++j) { TJob t = get_job(p, j); total += (t.Np >> 6) * (t.Kp >> 6); }
  float (*tile)[65] = (float (*)[65])smem;
  const int NADA = MODLD / 64;
  auto decode_tile = [&](int it_, TJob& t, int& n0, int& k0) {
    int j = 0, lt = it_;
    t = get_job(p, 0);
    while (true) {
      int n = (t.Np >> 6) * (t.Kp >> 6);
      if (lt < n) break;
      lt -= n; ++j; t = get_job(p, j);
    }
    const int nkt = t.Kp >> 6;
    n0 = (lt / nkt) * 64; k0 = (lt % nkt) * 64;
  };
  auto tile_load = [&](const TJob& t, int n0, int k0, float4& v0, float4& v1) {
    {
      const int kk = tid >> 4, n4 = (tid & 15) * 4;
      const int k = k0 + kk, n = n0 + n4;
      v0 = make_float4(0.f, 0.f, 0.f, 0.f);
      if (k < t.K && n < t.N) v0 = *(const float4*)(t.src + (size_t)k * t.N + n);
    }
    {
      const int kk = (tid + NT) >> 4, n4 = (tid & 15) * 4;
      const int k = k0 + kk, n = n0 + n4;
      v1 = make_float4(0.f, 0.f, 0.f, 0.f);
      if (k < t.K && n < t.N) v1 = *(const float4*)(t.src + (size_t)k * t.N + n);
    }
  };
  int it = blockIdx.x;
  {
    TJob t; int n0 = 0, k0 = 0; float4 v0, v1;
    if (it < total) { decode_tile(it, t, n0, k0); tile_load(t, n0, k0, v0, v1); }
    while (it < total) {
      {
        const int kk = tid >> 4, n4 = (tid & 15) * 4;
        tile[kk][n4] = v0.x; tile[kk][n4 + 1] = v0.y; tile[kk][n4 + 2] = v0.z; tile[kk][n4 + 3] = v0.w;
        tile[kk + 32][n4] = v1.x; tile[kk + 32][n4 + 1] = v1.y; tile[kk + 32][n4 + 2] = v1.z; tile[kk + 32][n4 + 3] = v1.w;
      }
      __syncthreads();
      const int itn = it + gridDim.x;
      TJob tn = t; int n0n = n0, k0n = k0;
      if (itn < total) { decode_tile(itn, tn, n0n, k0n); tile_load(tn, n0n, k0n, v0, v1); }
      {
        const int nn = tid >> 3, kk0 = (tid & 7) * 8;
        const int n = n0 + nn;
        const int drow = t.mode ? ((n >> 4) * 32 + t.which * 16 + (n & 15)) : n;
        float f[8];
#pragma unroll
        for (int q = 0; q < 8; ++q) f[q] = tile[kk0 + q][nn];
        *(uint4*)(t.dst + (size_t)drow * t.Kp + k0 + kk0) = pack8(f);
      }
      __syncthreads();
      t = tn; n0 = n0n; k0 = k0n; it = itn;
    }
  }
  for (; it < total + NADA; it += gridDim.x) {
    {
      const int a = it - total;
      const int ncol0 = a * 64;
      const float* W; const float* bias; int ldw, nl0;
      if (ncol0 < 12288) {
        int g = ncol0 / 3072;
        W = p.in[3] + (size_t)g * 1024 * 3072; bias = p.in[4] + g * 3072; ldw = 3072; nl0 = ncol0 - g * 3072;
      } else {
        W = p.in[25]; bias = p.in[26]; ldw = 2048; nl0 = ncol0 - 12288;
      }
      float* sc = (float*)smem;
      float* red = (float*)(smem + 16384);
      const float* c = p.in[1];
      for (int i = tid; i < 4096; i += NT) sc[i] = siluf_(c[i]);
      __syncthreads();
      const int w = tid >> 6, lane = tid & 63;
      float a0 = 0, a1 = 0, a2 = 0, a3 = 0;
      const float* wp = W + (size_t)(w * 128) * ldw + nl0 + lane;
#pragma unroll 8
      for (int k = 0; k < 128; ++k) {
        float wv = wp[(size_t)k * ldw];
        int kk = w * 128 + k;
        a0 += sc[kk] * wv; a1 += sc[1024 + kk] * wv; a2 += sc[2048 + kk] * wv; a3 += sc[3072 + kk] * wv;
      }
      red[(w * 4 + 0) * 64 + lane] = a0; red[(w * 4 + 1) * 64 + lane] = a1;
      red[(w * 4 + 2) * 64 + lane] = a2; red[(w * 4 + 3) * 64 + lane] = a3;
      __syncthreads();
      if (tid < 256) {
        int b = tid >> 6;
        float s = 0.f;
#pragma unroll
        for (int ww = 0; ww < 8; ++ww) s += red[(ww * 4 + b) * 64 + lane];
        float* mod = (float*)(p.ws + OFF_MOD);
        mod[b * MODLD + ncol0 + lane] = s + bias[nl0 + lane];
      }
      __syncthreads();
    }
  }
}

__device__ __forceinline__ void phase_norm(const float* __restrict__ x, const float* __restrict__ g1, const float* __restrict__ mod,
                           int sh1, int sc1, u16* __restrict__ o1,
                           const float* __restrict__ g2, int sh2, int sc2, u16* __restrict__ o2) {
  const int lane = threadIdx.x & 63;
  const int gw = blockIdx.x * NWV + (threadIdx.x >> 6);
  const int nw = gridDim.x * NWV;
  for (int row = gw; row < MT; row += nw) {
    const float4* xp = (const float4*)(x + (size_t)row * DM);
    float4 v[4];
    float ss = 0.f;
#pragma unroll
    for (int i = 0; i < 4; ++i) {
      v[i] = xp[lane + 64 * i];
      ss += v[i].x * v[i].x + v[i].y * v[i].y + v[i].z * v[i].z + v[i].w * v[i].w;
    }
    ss = wave_sum(ss);
    const float rs = rsqrtf(ss * (1.f / DM) + 1e-6f);
    const int b = row >> 13;
    const float* mb = mod + (size_t)b * MODLD;
#pragma unroll
    for (int i = 0; i < 4; ++i) {
      const int c = (lane + 64 * i) * 4;
      float4 gg = *(const float4*)(g1 + c);
      float4 sh = *(const float4*)(mb + sh1 + c);
      float4 sc = *(const float4*)(mb + sc1 + c);
      uint2 o;
      o.x = pack2(v[i].x * rs * gg.x * (1.f + sc.x) + sh.x, v[i].y * rs * gg.y * (1.f + sc.y) + sh.y);
      o.y = pack2(v[i].z * rs * gg.z * (1.f + sc.z) + sh.z, v[i].w * rs * gg.w * (1.f + sc.w) + sh.w);
      *(uint2*)(o1 + (size_t)row * DM + c) = o;
      if (o2) {
        float4 gg2 = *(const float4*)(g2 + c);
        float4 sh_ = *(const float4*)(mb + sh2 + c);
        float4 sc_ = *(const float4*)(mb + sc2 + c);
        uint2 q;
        q.x = pack2(v[i].x * rs * gg2.x * (1.f + sc_.x) + sh_.x, v[i].y * rs * gg2.y * (1.f + sc_.y) + sh_.y);
        q.y = pack2(v[i].z * rs * gg2.z * (1.f + sc_.z) + sh_.z, v[i].w * rs * gg2.w * (1.f + sc_.w) + sh_.w);
        *(uint2*)(o2 + (size_t)row * DM + c) = q;
      }
    }
  }
}

__device__ __forceinline__ void phase_norm_xs(const Params& p) {
  const float* x = p.in[0];
  const float* g1 = p.in[2];
  const float* mod = (const float*)(p.ws + OFF_MOD);
  const float* mu = p.in[5];
  const int lane = threadIdx.x & 63;
  const int gw = blockIdx.x * NWV + (threadIdx.x >> 6);
  const int nw = gridDim.x * NWV;
  float muv[6][2][8];
#pragma unroll
  for (int ch = 0; ch < 2; ++ch) {
    const int col = (lane + 64 * ch) * 8;
#pragma unroll
    for (int s6 = 0; s6 < 6; ++s6) {
      float4 m0 = *(const float4*)(mu + s6 * DM + col), m1 = *(const float4*)(mu + s6 * DM + col + 4);
      muv[s6][ch][0] = m0.x; muv[s6][ch][1] = m0.y; muv[s6][ch][2] = m0.z; muv[s6][ch][3] = m0.w;
      muv[s6][ch][4] = m1.x; muv[s6][ch][5] = m1.y; muv[s6][ch][6] = m1.z; muv[s6][ch][7] = m1.w;
    }
  }
  auto ldrow = [&](int row, float4* v, float4* u) {
    const bool first = (row & (TT - 1)) == 0;
    const float* xp = x + (size_t)row * DM;
    const float* xq = x + (size_t)(first ? row : row - 1) * DM;
#pragma unroll
    for (int ch = 0; ch < 2; ++ch) {
      const int col = (lane + 64 * ch) * 8;
      v[2 * ch] = *(const float4*)(xp + col); v[2 * ch + 1] = *(const float4*)(xp + col + 4);
      u[2 * ch] = *(const float4*)(xq + col); u[2 * ch + 1] = *(const float4*)(xq + col + 4);
    }
  };
  float4 v[4], u[4];
  int row = gw;
  if (row < MT) ldrow(row, v, u);
  for (; row < MT; row += nw) {
    float4 vn[4], un[4];
    const int rn = row + nw;
    ldrow(rn < MT ? rn : row, vn, un);
    __builtin_amdgcn_sched_barrier(0);
    const bool first = (row & (TT - 1)) == 0;
    float ss = 0.f, st = 0.f;
#pragma unroll
    for (int i = 0; i < 4; ++i) {
      ss += v[i].x * v[i].x + v[i].y * v[i].y + v[i].z * v[i].z + v[i].w * v[i].w;
      st += u[i].x * u[i].x + u[i].y * u[i].y + u[i].z * u[i].z + u[i].w * u[i].w;
    }
    ss = wave_sum(ss); st = wave_sum(st);
    const float rs = rsqrtf(ss * (1.f / DM) + 1e-6f);
    const float rt = first ? 0.f : rsqrtf(st * (1.f / DM) + 1e-6f);
    const float* mb = mod + (size_t)(row >> 13) * MODLD;
#pragma unroll
    for (int ch = 0; ch < 2; ++ch) {
      const int col = (lane + 64 * ch) * 8;
      float4 sh0 = *(const float4*)(mb + col), sh1 = *(const float4*)(mb + col + 4);
      float4 sc0 = *(const float4*)(mb + 1024 + col), sc1 = *(const float4*)(mb + 1024 + col + 4);
      float4 gm0 = *(const float4*)(g1 + col), gm1 = *(const float4*)(g1 + col + 4);
      const float gmv[8] = {gm0.x, gm0.y, gm0.z, gm0.w, gm1.x, gm1.y, gm1.z, gm1.w};
      const float sh[8] = {sh0.x, sh0.y, sh0.z, sh0.w, sh1.x, sh1.y, sh1.z, sh1.w};
      const float sc[8] = {sc0.x, sc0.y, sc0.z, sc0.w, sc1.x, sc1.y, sc1.z, sc1.w};
      const float xv[8] = {v[2 * ch].x, v[2 * ch].y, v[2 * ch].z, v[2 * ch].w, v[2 * ch + 1].x, v[2 * ch + 1].y, v[2 * ch + 1].z, v[2 * ch + 1].w};
      const float uv[8] = {u[2 * ch].x, u[2 * ch].y, u[2 * ch].z, u[2 * ch].w, u[2 * ch + 1].x, u[2 * ch + 1].y, u[2 * ch + 1].z, u[2 * ch + 1].w};
      float h[8], d[8];
#pragma unroll
      for (int e = 0; e < 8; ++e) {
        const float gg = gmv[e] * (1.f + sc[e]);
        h[e] = xv[e] * rs * gg + sh[e];
        const float q = first ? 0.f : (uv[e] * rt * gg + sh[e]);
        d[e] = q - h[e];
      }
#pragma unroll
      for (int s6 = 0; s6 < 6; ++s6) {
        float o[8];
#pragma unroll
        for (int e = 0; e < 8; ++e) o[e] = h[e] + d[e] * muv[s6][ch][e];
        *(uint4*)((u16*)(p.ws + SLOT(s6)) + (size_t)row * DM + col) = pack8(o);
      }
    }
#pragma unroll
    for (int i = 0; i < 4; ++i) { v[i] = vn[i]; u[i] = un[i]; }
  }
}

enum { EPI_BF16 = 0, EPI_TANH, EPI_SIG, EPI_DECAY, EPI_AK, EPI_RESID, EPI_SWIGLU, EPI_HEADNORM, EPI_VT };
struct Epi {
  u16* o16; float* o32; const float* res; const float* gate; int ldo;
  const float* v0; const float* v1; const float* v2;
  u16* kbuf; u16* kkbuf; u16* abbuf;
};

constexpr int G_BK = 64, G_HALF = 128, G_HT = G_HALF * G_BK;

__device__ __forceinline__ int lds_byte(int r, int c) {
  int st = (r >> 4) * 2 + (c >> 5), rr = r & 15, cc = c & 31, ob = rr * 64 + cc * 2;
  return st * 1024 + (ob ^ (((ob >> 9) & 1) << 5));
}
__device__ __forceinline__ void stage_rc(int b, int& R, int& C) {
  int st = b / 1024, sb = b % 1024, swz = sb ^ (((sb >> 9) & 1) << 5);
  R = (st >> 1) * 16 + swz / 64; C = (st & 1) * 32 + (swz % 64) / 2;
}

#define IS(x) ((((EPISET) >> (x)) & 1) && epi == (x))
template <int EPISET, bool PF = false>
__device__ __forceinline__ void gemm_tile(const u16* __restrict__ A, const u16* __restrict__ Bt, const int K,
                                          const int brow, const int bcol, const int epi, const Epi& e, unsigned char* smem,
                                          const bool pf_first = true, const bool pf_next = false, const int nbrow = 0, const int nbcol = 0) {
  u16* shm = (u16*)smem;
#define SA(b, h) (shm + ((b) * 2 + (h)) * G_HT)
#define SB(b, h) (shm + (4 + (b) * 2 + (h)) * G_HT)
#define STAGE(P, BASE, br, kt) do { const char* _gb = (const char*)((BASE) + (long)(br) * K + (long)(kt) * G_BK); \
      __builtin_amdgcn_global_load_lds((const unsigned*)(_gb + (size_t)voff), \
        (__attribute__((address_space(3))) unsigned*)((char*)(P) + threadIdx.x * 16), 16, 0, 0); \
      __builtin_amdgcn_global_load_lds((const unsigned*)(_gb + (size_t)K * 128 + (size_t)voff), \
        (__attribute__((address_space(3))) unsigned*)((char*)(P) + threadIdx.x * 16 + 8192), 16, 0, 0); } while (0)
#define LDA(dst, b, h) for (int m = 0; m < 4; ++m) for (int k = 0; k < 2; ++k) \
    dst[m][k] = *reinterpret_cast<const bf16x8*>((char*)SA(b, h) + lds_byte(wr * 64 + m * 16 + fr, k * 32 + fq * 8))
#define LDB(dst, b, h) for (int n = 0; n < 2; ++n) for (int k = 0; k < 2; ++k) \
    dst[n][k] = *reinterpret_cast<const bf16x8*>((char*)SB(b, h) + lds_byte(wc * 32 + n * 16 + fr, k * 32 + fq * 8))
#define MMA(ai, bj, At_, Bt_) do { __builtin_amdgcn_s_setprio(1); \
    for (int m = 0; m < 4; ++m) for (int n = 0; n < 2; ++n) for (int k = 0; k < 2; ++k) \
      acc[ai][bj][m][n] = __builtin_amdgcn_mfma_f32_16x16x32_bf16(At_[m][k], Bt_[n][k], acc[ai][bj][m][n], 0, 0, 0); \
    __builtin_amdgcn_s_setprio(0); } while (0)
#define WAIT_V(n) asm volatile("s_waitcnt vmcnt(" #n ")" ::: "memory")
#define WAIT_L(n) asm volatile("s_waitcnt lgkmcnt(" #n ")" ::: "memory")
#define BAR __builtin_amdgcn_s_barrier()
#define SCHED __builtin_amdgcn_sched_barrier(0)
  const int tid = threadIdx.x;
  const int wid = tid >> 6, lane = tid & 63, wr = wid >> 2, wc = wid & 3, fr = lane & 15, fq = lane >> 4;
  f32x4 acc[2][2][4][2] = {};
  bf16x8 At[4][2], B0[2][2], B1[2][2];
  int nt = K / G_BK;
  asm volatile("" : "+s"(nt));
  unsigned voff;
  { int _r, _c; stage_rc(tid * 16, _r, _c); voff = (unsigned)(_r * K + _c) * 2u; }
  if (!PF || pf_first) {
    __syncthreads();
    STAGE(SB(0, 0), Bt, bcol, 0); STAGE(SA(0, 0), A, brow, 0);
    STAGE(SB(0, 1), Bt, bcol + G_HALF, 0); STAGE(SA(0, 1), A, brow + G_HALF, 0);
  } else {
    WAIT_L(0); BAR;
  }
  if (wr == 1) BAR;
  WAIT_V(4); BAR;
  STAGE(SB(1, 0), Bt, bcol, 1); STAGE(SA(1, 0), A, brow, 1); STAGE(SB(1, 1), Bt, bcol + G_HALF, 1);
  WAIT_V(6); BAR;
#pragma unroll 1
  for (int t = 0; t < nt - 2; t += 2) {
    LDB(B0, 0, 0); SCHED; LDA(At, 0, 0); STAGE(SA(1, 1), A, brow + G_HALF, t + 1);
    WAIT_L(8); BAR; WAIT_L(0); MMA(0, 0, At, B0); BAR; SCHED;
    LDB(B1, 0, 1); STAGE(SB(0, 0), Bt, bcol, t + 2);
    BAR; WAIT_L(0); MMA(0, 1, At, B1); BAR;
    LDA(At, 0, 1); STAGE(SA(0, 0), A, brow, t + 2);
    BAR; WAIT_L(0); MMA(1, 0, At, B0); BAR; SCHED;
    STAGE(SB(0, 1), Bt, bcol + G_HALF, t + 2);
    WAIT_V(6); BAR; MMA(1, 1, At, B1); BAR;
    LDB(B0, 1, 0); SCHED; LDA(At, 1, 0); STAGE(SA(0, 1), A, brow + G_HALF, t + 2);
    WAIT_L(8); BAR; WAIT_L(0); MMA(0, 0, At, B0); BAR; SCHED;
    LDB(B1, 1, 1); STAGE(SB(1, 0), Bt, bcol, t + 3);
    BAR; WAIT_L(0); MMA(0, 1, At, B1); BAR;
    LDA(At, 1, 1); STAGE(SA(1, 0), A, brow, t + 3);
    BAR; WAIT_L(0); MMA(1, 0, At, B0); BAR; SCHED;
    STAGE(SB(1, 1), Bt, bcol + G_HALF, t + 3);
    WAIT_V(6); BAR; MMA(1, 1, At, B1); BAR;
  }
  { LDB(B0, 0, 0); LDA(At, 0, 0); STAGE(SA(1, 1), A, brow + G_HALF, nt - 1);
    BAR; WAIT_L(0); MMA(0, 0, At, B0); BAR;
    LDB(B1, 0, 1); BAR; WAIT_L(0); MMA(0, 1, At, B1); BAR;
    LDA(At, 0, 1); WAIT_V(4); BAR; WAIT_L(0); MMA(1, 0, At, B0); MMA(1, 1, At, B1); BAR; }
  { LDB(B0, 1, 0); LDA(At, 1, 0); WAIT_V(2); BAR; WAIT_L(0); MMA(0, 0, At, B0); BAR;
    LDB(B1, 1, 1); WAIT_V(0); BAR; WAIT_L(0); MMA(0, 1, At, B1); BAR;
    LDA(At, 1, 1); BAR; WAIT_L(0); MMA(1, 0, At, B0); MMA(1, 1, At, B1); BAR; }
  if (wr == 0) BAR;

  int tid_e;
  asm volatile("v_mov_b32 %0, %1" : "=v"(tid_e) : "v"(tid));
  const int wid_e = tid_e >> 6, lane_e = tid_e & 63, wr_e = wid_e >> 2, wc_e = wid_e & 3, fr_e = lane_e & 15, fq_e = lane_e >> 4;
#pragma unroll
  for (int ai = 0; ai < 2; ++ai)
#pragma unroll
    for (int bj = 0; bj < 2; ++bj) {
      const bool lastq = PF && (ai * 2 + bj) == 3;
      float* stg = lastq ? (float*)(smem + 98304) : (float*)(smem + ((ai * 2 + bj) & 1) * STG_BYTES);
      const int LD = lastq ? 128 : STG_LD;
      if (IS(EPI_VT)) {
#pragma unroll
        for (int m = 0; m < 4; ++m)
#pragma unroll
          for (int n = 0; n < 2; ++n) {
            f32x4 a4 = acc[ai][bj][m][n];
            *(float4*)(stg + (wc_e * 32 + n * 16 + fr_e) * LD + wr_e * 64 + m * 16 + fq_e * 4) = make_float4(a4[0], a4[1], a4[2], a4[3]);
          }
      } else {
#pragma unroll
        for (int m = 0; m < 4; ++m)
#pragma unroll
          for (int n = 0; n < 2; ++n)
#pragma unroll
            for (int j = 0; j < 4; ++j)
              stg[(wr_e * 64 + m * 16 + fq_e * 4 + j) * LD + wc_e * 32 + n * 16 + fr_e] = acc[ai][bj][m][n][j];
      }
      __syncthreads();
      if (lastq && pf_next) {
        STAGE(SB(0, 0), Bt, nbcol, 0); STAGE(SA(0, 0), A, nbrow, 0);
        STAGE(SB(0, 1), Bt, nbcol + G_HALF, 0); STAGE(SA(0, 1), A, nbrow + G_HALF, 0);
      }
      const int r0 = brow + ai * 128, c0 = bcol + bj * 128;
      if (IS(EPI_SWIGLU)) {
#pragma unroll
        for (int i = 0; i < 2; ++i) {
          const int item = tid_e + NT * i;
          const int row = item >> 3, o0 = (item & 7) * 8;
          const int gc = (o0 >> 4) * 32 + (o0 & 15);
          const float* sp = stg + row * LD + gc;
          float4 g0 = *(const float4*)(sp), g1 = *(const float4*)(sp + 4);
          float4 u0 = *(const float4*)(sp + 16), u1 = *(const float4*)(sp + 20);
          float o[8] = {siluf_(g0.x) * u0.x, siluf_(g0.y) * u0.y, siluf_(g0.z) * u0.z, siluf_(g0.w) * u0.w,
                        siluf_(g1.x) * u1.x, siluf_(g1.y) * u1.y, siluf_(g1.z) * u1.z, siluf_(g1.w) * u1.w};
          *(uint4*)(e.o16 + (size_t)(r0 + row) * FF + (c0 >> 1) + o0) = pack8(o);
        }
      } else if (IS(EPI_VT)) {
#pragma unroll 1
        for (int i = 0; i < 4; ++i) {
          const int item = tid_e + NT * i;
          const int kg = item & 15, dl = item >> 4;
          const float* sp = stg + dl * LD + kg * 8;
          float4 a = *(const float4*)sp, b4 = *(const float4*)(sp + 4);
          float o[8] = {a.x, a.y, a.z, a.w, b4.x, b4.y, b4.z, b4.w};
          const int tok = r0 + kg * 8;
          const int b = tok >> 13, t = tok & (TT - 1), nblk = t >> 8, key = t & 255;
          const int col = c0 + dl, h = col >> 6, d = col & 63;
          *(uint4*)(e.o16 + ((size_t)(((b * 16 + h) * 32 + nblk) * 64 + d)) * 256 + key) = pack8(o);
        }
      } else {
#pragma unroll 1
        for (int i = 0; i < 4; ++i) {
          const int row = (tid_e >> 4) + 32 * i, cg = tid_e & 15;
          const float* sp = stg + row * LD + cg * 8;
          float4 a = *(const float4*)sp, b4 = *(const float4*)(sp + 4);
          float v[8] = {a.x, a.y, a.z, a.w, b4.x, b4.y, b4.z, b4.w};
          const int grow = r0 + row, gcol = c0 + cg * 8;
          if (IS(EPI_BF16) || IS(EPI_TANH) || IS(EPI_SIG)) {
#pragma unroll
            for (int q = 0; q < 8; ++q) {
              if (IS(EPI_TANH)) v[q] = tanhf_(v[q]);
              if (IS(EPI_SIG)) v[q] = sigmoidf_(v[q]);
            }
            *(uint4*)(e.o16 + (size_t)grow * e.ldo + gcol) = pack8(v);
          } else if (IS(EPI_DECAY)) {
            float4 w0a = *(const float4*)(e.v0 + gcol), w0b = *(const float4*)(e.v0 + gcol + 4);
            float w0[8] = {w0a.x, w0a.y, w0a.z, w0a.w, w0b.x, w0b.y, w0b.z, w0b.w};
            float o[8];
#pragma unroll
            for (int q = 0; q < 8; ++q) {
              o[q] = __expf(-0.60653066f * sigmoidf_(w0[q] + v[q]));
            }
            float* op = e.o32 + (size_t)grow * DM + gcol;
            *(float4*)op = make_float4(o[0], o[1], o[2], o[3]);
            *(float4*)(op + 4) = make_float4(o[4], o[5], o[6], o[7]);
          } else if (IS(EPI_AK)) {
            const size_t off = (size_t)grow * DM + gcol;
            float kv[8]; unpack8(*(const uint4*)(e.kbuf + off), kv);
            float4 t0 = *(const float4*)(e.v0 + gcol), t1 = *(const float4*)(e.v0 + gcol + 4);
            float a0[8] = {t0.x, t0.y, t0.z, t0.w, t1.x, t1.y, t1.z, t1.w};
            t0 = *(const float4*)(e.v1 + gcol); t1 = *(const float4*)(e.v1 + gcol + 4);
            float kkc[8] = {t0.x, t0.y, t0.z, t0.w, t1.x, t1.y, t1.z, t1.w};
            t0 = *(const float4*)(e.v2 + gcol); t1 = *(const float4*)(e.v2 + gcol + 4);
            float kac[8] = {t0.x, t0.y, t0.z, t0.w, t1.x, t1.y, t1.z, t1.w};
            float kkv[8], ss = 0.f;
#pragma unroll
            for (int q = 0; q < 8; ++q) { kkv[q] = kv[q] * kkc[q]; ss += kkv[q] * kkv[q]; }
            ss += __shfl_xor(ss, 1); ss += __shfl_xor(ss, 2); ss += __shfl_xor(ss, 4);
            const float inv = fminf(__builtin_amdgcn_rsqf(ss), 1e12f);
            float o1[8], o2[8], o3[8];
#pragma unroll
            for (int q = 0; q < 8; ++q) {
              const float aa = sigmoidf_(a0[q] + v[q]);
              const float kkn = kkv[q] * inv;
              o1[q] = kv[q] * (1.f + (aa - 1.f) * kac[q]);
              o2[q] = kkn;
              o3[q] = kkn * aa;
            }
            *(uint4*)(e.kbuf + off) = pack8(o1);
            *(uint4*)(e.kkbuf + off) = pack8(o2);
            *(uint4*)(e.abbuf + off) = pack8(o3);
          } else if (IS(EPI_RESID)) {
            const size_t off = (size_t)grow * DM + gcol;
            const float* gp = e.gate + (size_t)(grow >> 13) * MODLD + gcol;
            float4 r0v = *(const float4*)(e.res + off), r1v = *(const float4*)(e.res + off + 4);
            float4 g0 = *(const float4*)gp, g1 = *(const float4*)(gp + 4);
            *(float4*)(e.o32 + off) = make_float4(r0v.x + g0.x * v[0], r0v.y + g0.y * v[1], r0v.z + g0.z * v[2], r0v.w + g0.w * v[3]);
            *(float4*)(e.o32 + off + 4) = make_float4(r1v.x + g1.x * v[4], r1v.y + g1.y * v[5], r1v.z + g1.z * v[6], r1v.w + g1.w * v[7]);
          } else if (IS(EPI_HEADNORM)) {
            float ss = 0.f;
#pragma unroll
            for (int q = 0; q < 8; ++q) ss += v[q] * v[q];
            ss += __shfl_xor(ss, 1); ss += __shfl_xor(ss, 2); ss += __shfl_xor(ss, 4);
            const float rs = rsqrtf(ss * (1.f / 64.f) + 1e-6f);
            float4 t0 = *(const float4*)(e.v0 + (gcol & 63)), t1 = *(const float4*)(e.v0 + (gcol & 63) + 4);
            float gn[8] = {t0.x, t0.y, t0.z, t0.w, t1.x, t1.y, t1.z, t1.w};
#pragma unroll
            for (int q = 0; q < 8; ++q) v[q] = v[q] * rs * gn[q];
            *(uint4*)(e.o16 + (size_t)grow * DM + gcol) = pack8(v);
          }
        }
      }
    }
}

#undef SA
#undef SB
#undef STAGE
#undef LDA
#undef LDB
#undef MMA
#undef WAIT_V
#undef WAIT_L
#undef BAR
#undef SCHED

__device__ __forceinline__ int tile_remap(int i) {
  const int G = gridDim.x;
  const int b = i % G, r = i / G;
  const int per = G >> 3;
  return r * G + (b & 7) * per + (b >> 3);
}

typedef float v2f __attribute__((ext_vector_type(2)));
constexpr int SC_TC = 16;
constexpr int SC_BUF = 5 * SC_TC * 64 * 4 + SC_TC * 16 * 4;
struct ScanRegs { uint4 a, b; float4 d; uint2 v; };

__device__ __forceinline__ void phase_scan(const Params& p, unsigned char* smem) {
  if (blockIdx.x >= 256) return;
  const int sb = blockIdx.x, bh = sb & 63, rg = sb >> 6;
  const int b = bh >> 4, h = bh & 15;
  const size_t base = (size_t)b * TT * DM + h * 64;
  const u16* Rb = (const u16*)(p.ws + SLOT(6));
  const u16* Kb = (const u16*)DSLOT(p, 0);
  const u16* Vb = (const u16*)DSLOT(p, 1);
  const u16* KKb = (const u16*)(p.ws + SLOT(3));
  const u16* ABb = (const u16*)(p.ws + SLOT(4));
  const float* DECb = (const float*)(p.ws + SLOT(1));
  u16* Yb = (u16*)(p.ws + SLOT(0));
  if (threadIdx.x >= 256) {
    const int tid = threadIdx.x - 256;
    const int ls = (tid & 127) >> 3, lc8 = tid & 7, pair = tid >> 7;
    const u16* pa = (pair ? KKb : Rb) + base + (size_t)ls * DM + lc8 * 8;
    const u16* pb = (pair ? ABb : Kb) + base + (size_t)ls * DM + lc8 * 8;
    const float* pd = DECb + base + (size_t)(tid >> 4) * DM + (tid & 15) * 4;
    const u16* pv = Vb + base + (size_t)((tid & 63) >> 2) * DM + rg * 16 + (tid & 3) * 4;
    auto gload = [&](ScanRegs& R, int t0) {
      const size_t o = (size_t)t0 * DM;
      R.a = *(const uint4*)(pa + o);
      R.b = *(const uint4*)(pb + o);
      R.d = *(const float4*)(pd + o);
      R.v = *(const uint2*)(pv + o);
    };
    auto lstore = [&](const ScanRegs& R, int buf) {
      float* L = (float*)(smem + buf * SC_BUF);
      float* la = L + (pair ? 2 : 0) * (SC_TC * 64) + ls * 64 + lc8 * 8;
      float* lb = L + (pair ? 3 : 1) * (SC_TC * 64) + ls * 64 + lc8 * 8;
      const float sg = pair ? -1.f : 1.f;
      *(float4*)(la) = make_float4(sg * bflo(R.a.x), sg * bfhi(R.a.x), sg * bflo(R.a.y), sg * bfhi(R.a.y));
      *(float4*)(la + 4) = make_float4(sg * bflo(R.a.z), sg * bfhi(R.a.z), sg * bflo(R.a.w), sg * bfhi(R.a.w));
      *(float4*)(lb) = make_float4(bflo(R.b.x), bfhi(R.b.x), bflo(R.b.y), bfhi(R.b.y));
      *(float4*)(lb + 4) = make_float4(bflo(R.b.z), bfhi(R.b.z), bflo(R.b.w), bfhi(R.b.w));
      *(float4*)(L + 4 * (SC_TC * 64) + (tid >> 4) * 64 + (tid & 15) * 4) = R.d;
      if (tid < 64) *(float4*)(L + 5 * (SC_TC * 64) + (tid >> 2) * 16 + (tid & 3) * 4) = make_float4(bflo(R.v.x), bfhi(R.v.x), bflo(R.v.y), bfhi(R.v.y));
    };
    ScanRegs X, Y;
    gload(X, 0);
    lstore(X, 0);
    gload(X, SC_TC);
    gload(Y, 2 * SC_TC);
    __syncthreads();
#pragma unroll 1
    for (int t0 = 0; t0 < TT; t0 += 2 * SC_TC) {
      lstore(X, 1);
      gload(X, min(t0 + 3 * SC_TC, TT - SC_TC));
      __syncthreads();
      lstore(Y, 0);
      gload(Y, min(t0 + 4 * SC_TC, TT - SC_TC));
      __syncthreads();
    }
  } else {
    const int tid = threadIdx.x, w = tid >> 6, lane = tid & 63;
    const int rl = lane >> 4, cl = lane & 15;
    const int row = rg * 16 + w * 4 + rl;
    u16* yp = Yb + base + row + (size_t)cl * DM;
    float S0 = 0.f, S1 = 0.f, S2 = 0.f, S3 = 0.f;
    struct StepIn { float4 r4, k4, n4, b4, d4; float v; };
    auto ldsload = [&](const float* L, int s) {
      StepIn q;
      q.n4 = *(const float4*)(L + 2 * (SC_TC * 64) + s * 64 + cl * 4);
      q.b4 = *(const float4*)(L + 3 * (SC_TC * 64) + s * 64 + cl * 4);
      q.d4 = *(const float4*)(L + 4 * (SC_TC * 64) + s * 64 + cl * 4);
      q.k4 = *(const float4*)(L + 1 * (SC_TC * 64) + s * 64 + cl * 4);
      q.v = L[5 * (SC_TC * 64) + s * 16 + w * 4 + rl];
      q.r4 = *(const float4*)(L + 0 * (SC_TC * 64) + s * 64 + cl * 4);
      return q;
    };
    float rp0 = 0.f, rp1 = 0.f, rp2 = 0.f, rp3 = 0.f;
    float yacc = 0.f;
    auto step = [&](const StepIn& c) -> float {
      float t0, t1, y0, y1, u0, u1, u2, u3;
      asm volatile(
          "v_mul_f32 %0, %8, %12\n\t"
          "v_mul_f32 %2, %8, %16\n\t"
          "v_mul_f32 %1, %10, %14\n\t"
          "v_mul_f32 %3, %10, %18\n\t"
          "v_fmac_f32 %0, %9, %13\n\t"
          "v_fmac_f32 %2, %9, %17\n\t"
          "v_fmac_f32 %1, %11, %15\n\t"
          "v_fmac_f32 %3, %11, %19\n\t"
          "v_add_f32 %0, %0, %1\n\t"
          "v_add_f32 %2, %2, %3\n\t"
          "v_mul_f32 %4, %20, %21\n\t"
          "v_add_f32_dpp %0, %0, %0 quad_perm:[1,0,3,2] row_mask:0xf bank_mask:0xf bound_ctrl:1\n\t"
          "v_add_f32_dpp %2, %2, %2 quad_perm:[1,0,3,2] row_mask:0xf bank_mask:0xf bound_ctrl:1\n\t"
          "v_mul_f32 %5, %20, %22\n\t"
          "v_add_f32_dpp %0, %0, %0 quad_perm:[2,3,0,1] row_mask:0xf bank_mask:0xf bound_ctrl:1\n\t"
          "v_add_f32_dpp %2, %2, %2 quad_perm:[2,3,0,1] row_mask:0xf bank_mask:0xf bound_ctrl:1\n\t"
          "v_mul_f32 %6, %20, %23\n\t"
          "v_add_f32_dpp %0, %0, %0 row_ror:4 row_mask:0xf bank_mask:0xf bound_ctrl:1\n\t"
          "v_add_f32_dpp %2, %2, %2 row_ror:4 row_mask:0xf bank_mask:0xf bound_ctrl:1\n\t"
          "v_mul_f32 %7, %20, %24\n\t"
          "v_add_f32_dpp %0, %0, %0 row_ror:8 row_mask:0xf bank_mask:0xf bound_ctrl:1\n\t"
          "v_add_f32_dpp %2, %2, %2 row_ror:8 row_mask:0xf bank_mask:0xf bound_ctrl:1\n\t"
          : "=&v"(t0), "=&v"(t1), "=&v"(y0), "=&v"(y1), "=&v"(u0), "=&v"(u1), "=&v"(u2), "=&v"(u3)
          : "v"(S0), "v"(S1), "v"(S2), "v"(S3), "v"(c.n4.x), "v"(c.n4.y), "v"(c.n4.z), "v"(c.n4.w),
            "v"(rp0), "v"(rp1), "v"(rp2), "v"(rp3), "v"(c.v), "v"(c.k4.x), "v"(c.k4.y), "v"(c.k4.z), "v"(c.k4.w));
      asm volatile(
          "v_fmac_f32 %4, %8, %9\n\t"
          "v_fmac_f32 %5, %8, %10\n\t"
          "v_fmac_f32 %6, %8, %11\n\t"
          "v_fmac_f32 %7, %8, %12\n\t"
          "v_fma_f32 %0, %0, %13, %4\n\t"
          "v_fma_f32 %1, %1, %14, %5\n\t"
          "v_fma_f32 %2, %2, %15, %6\n\t"
          "v_fma_f32 %3, %3, %16, %7\n\t"
          : "+v"(S0), "+v"(S1), "+v"(S2), "+v"(S3), "+v"(u0), "+v"(u1), "+v"(u2), "+v"(u3)
          : "v"(t0), "v"(c.b4.x), "v"(c.b4.y), "v"(c.b4.z), "v"(c.b4.w), "v"(c.d4.x), "v"(c.d4.y), "v"(c.d4.z), "v"(c.d4.w));
      rp0 = c.r4.x; rp1 = c.r4.y; rp2 = c.r4.z; rp3 = c.r4.w;
      return y0;
    };
    auto compute = [&](int buf, int t0) {
      const float* L = (const float*)(smem + buf * SC_BUF);
      StepIn cur = ldsload(L, 0);
#pragma unroll
      for (int s = 0; s < SC_TC; ++s) {
        StepIn nxt = cur;
        if (s + 1 < SC_TC) nxt = ldsload(L, s + 1);
        const float y = step(cur);
        if (s == 0) {
          yacc = (cl == 15) ? y : yacc;
          if (t0 > 0) yp[(size_t)(t0 - SC_TC) * DM] = f2bf(yacc);
        } else {
          yacc = (cl == s - 1) ? y : yacc;
        }
        cur = nxt;
        if ((s & 3) == 3) __builtin_amdgcn_sched_barrier(0);
      }
    };
    __syncthreads();
#pragma unroll 1
    for (int t0 = 0; t0 < TT; t0 += 2 * SC_TC) {
      compute(0, t0);
      __syncthreads();
      compute(1, t0 + SC_TC);
      __syncthreads();
    }
    {
      float y = (S0 * rp0 + S1 * rp1) + (S2 * rp2 + S3 * rp3);
      y = allreduce16(y);
      yacc = (cl == 15) ? y : yacc;
      yp[(size_t)(TT - SC_TC) * DM] = f2bf(yacc);
    }
  }
}

__device__ __forceinline__ void phase_gn(const Params& p) {
  const u16* R = (const u16*)(p.ws + SLOT(6));
  const u16* Kp = (const u16*)DSLOT(p, 0);
  const u16* V = (const u16*)DSLOT(p, 1);
  const u16* G = (const u16*)(p.ws + SLOT(5));
  u16* Y = (u16*)(p.ws + SLOT(0));
  const float* rk = p.in[17];
  const float* lg = p.in[18];
  const float* lb = p.in[19];
  const size_t nchunks = (size_t)MT * 128;
  const size_t stride = (size_t)gridDim.x * NT;
  for (size_t q = (size_t)blockIdx.x * NT + threadIdx.x; q < nchunks; q += stride) {
    const size_t off = q * 8;
    const int c = (int)(off & (DM - 1));
    float y[8], r[8], k[8], v[8], g[8];
    unpack8(*(const uint4*)(Y + off), y); unpack8(*(const uint4*)(R + off), r); unpack8(*(const uint4*)(Kp + off), k);
    unpack8(*(const uint4*)(V + off), v); unpack8(*(const uint4*)(G + off), g);
    float s = 0.f, rks = 0.f;
#pragma unroll
    for (int i = 0; i < 8; ++i) { s += y[i]; rks += r[i] * k[i] * rk[c + i]; }
    s += __shfl_xor(s, 1); s += __shfl_xor(s, 2); s += __shfl_xor(s, 4);
    rks += __shfl_xor(rks, 1); rks += __shfl_xor(rks, 2); rks += __shfl_xor(rks, 4);
    const float mean = s * (1.f / 64.f);
    float vs = 0.f;
#pragma unroll
    for (int i = 0; i < 8; ++i) { float d = y[i] - mean; vs += d * d; }
    vs += __shfl_xor(vs, 1); vs += __shfl_xor(vs, 2); vs += __shfl_xor(vs, 4);
    const float rstd = rsqrtf(vs * (1.f / 64.f) + 64e-5f);
    float z[8];
#pragma unroll
    for (int i = 0; i < 8; ++i) z[i] = ((y[i] - mean) * rstd * lg[c + i] + lb[c + i] + rks * v[i]) * g[i];
    *(uint4*)(Y + off) = pack8(z);
  }
}

__device__ __forceinline__ void phase_kmean(const Params& p) {
  const u16* Kb = (const u16*)(p.ws + SLOT(1));
  float* km = (float*)(p.ws + OFF_KMEAN);
  const int lane = threadIdx.x & 63;
  const int gw = blockIdx.x * NWV + (threadIdx.x >> 6), nw = gridDim.x * NWV;
  for (int it = gw; it < 2048; it += nw) {
    const int bh = it >> 5, n = it & 31, b = bh >> 4, h = bh & 15;
    const u16* kp = Kb + ((size_t)b * TT + n * 256 + (lane >> 3)) * DM + h * 64 + (lane & 7) * 8;
    float s[8] = {0.f, 0.f, 0.f, 0.f, 0.f, 0.f, 0.f, 0.f};
#pragma unroll 8
    for (int j = 0; j < 32; ++j) {
      float f[8]; unpack8(*(const uint4*)(kp + (size_t)j * 8 * DM), f);
#pragma unroll
      for (int q = 0; q < 8; ++q) s[q] += f[q];
    }
#pragma unroll
    for (int q = 0; q < 8; ++q) { s[q] += __shfl_xor(s[q], 8); s[q] += __shfl_xor(s[q], 16); s[q] += __shfl_xor(s[q], 32); }
    if (lane < 8) {
      float* o = km + (size_t)it * 64 + lane * 8;
      *(float4*)o = make_float4(s[0] * (1.f / 256.f), s[1] * (1.f / 256.f), s[2] * (1.f / 256.f), s[3] * (1.f / 256.f));
      *(float4*)(o + 4) = make_float4(s[4] * (1.f / 256.f), s[5] * (1.f / 256.f), s[6] * (1.f / 256.f), s[7] * (1.f / 256.f));
    }
  }
}

__device__ __forceinline__ void phase_gate(const Params& p) {
  const u16* Q = (const u16*)(p.ws + SLOT(4));
  const float* km = (const float*)(p.ws + OFF_KMEAN);
  int* cnt = (int*)(p.ws + OFF_CNT);
  u16* lists = (u16*)(p.ws + SLOT(5));
  float* lse = (float*)(p.ws + OFF_LSE);
  const int lane = threadIdx.x & 63;
  const int gw = blockIdx.x * NWV + (threadIdx.x >> 6), nw = gridDim.x * NWV;
  for (int it0 = gw; it0 < 8192; it0 += nw) {
    const int it = __builtin_amdgcn_readfirstlane(it0);
    const int bh = it >> 7, qg = it & 127, b = bh >> 4, h = bh & 15;
    const int blk = qg >> 2;
    const int t = qg * 64 + lane;
    const size_t m = (size_t)b * TT + t;
    float q[64];
    {
      const uint4* qp = (const uint4*)(Q + m * DM + h * 64);
#pragma unroll
      for (int i = 0; i < 8; ++i) unpack8(qp[i], q + 8 * i);
    }
    float s0 = -3e38f, s1 = -3e38f, s2 = -3e38f;
    int i0 = 0, i1 = 0, i2 = 0;
    for (int n = 0; n < blk; ++n) {
      const float* kr = km + ((size_t)bh * 32 + n) * 64;
      float s = 0.f;
#pragma unroll
      for (int d = 0; d < 64; ++d) s += q[d] * kr[d];
      if (s > s0) { s2 = s1; i2 = i1; s1 = s0; i1 = i0; s0 = s; i0 = n; }
      else if (s > s1) { s2 = s1; i2 = i1; s1 = s; i1 = n; }
      else if (s > s2) { s2 = s; i2 = n; }
    }
    const int nsel = min(3, blk);
    unsigned long long mymask = 0ull;
    for (int n = 0; n < blk; ++n) {
      const bool sel = (i0 == n) || (nsel > 1 && i1 == n) || (nsel > 2 && i2 == n);
      const unsigned long long mk = __ballot(sel);
      if (lane == n) mymask = mk;
    }
    const int tot = __popcll(mymask);
    int base = 0;
    if (lane < blk && tot > 0) base = atomicAdd(&cnt[bh * 32 + lane], tot);
    const unsigned mlo = (unsigned)mymask, mhi = (unsigned)(mymask >> 32);
    const unsigned long long below = (1ull << lane) - 1ull;
#pragma unroll
    for (int s = 0; s < 3; ++s) {
      const int n = (s == 0) ? i0 : (s == 1) ? i1 : i2;
      const unsigned lo = __shfl(mlo, n), hi = __shfl(mhi, n);
      const int bs = __shfl(base, n);
      if (s < nsel) {
        const unsigned long long mk = ((unsigned long long)hi << 32) | lo;
        const int pos = bs + __popcll(mk & below);
        lists[(size_t)(bh * 32 + n) * 8192 + pos] = (u16)(t | (s << 13));
      } else {
        lse[(size_t)s * MT * 16 + m * 16 + h] = -1e30f;
      }
    }
  }
}

constexpr int VT_LD = 528;
__device__ __forceinline__ int swz(int row, int chunk) { return row * 128 + ((chunk ^ ((row >> 1) & 7)) << 4); }

template <bool OWN>
__device__ __forceinline__ void attn_tile(const bf16x8 q0, const bf16x8 q1, int tloc, const unsigned char* smem,
                                          float& mout, float& lout, f32x4 O[4]) {
  const int lane = threadIdx.x & 63, g = lane >> 4, c16 = lane & 15;
  f32x4 S[16];
#pragma unroll
  for (int kt = 0; kt < 16; ++kt) {
    const int row = kt * 16 + c16;
    bf16x8 k0 = *(const bf16x8*)(smem + swz(row, g));
    bf16x8 k1 = *(const bf16x8*)(smem + swz(row, g + 4));
    f32x4 z = (f32x4){0.f, 0.f, 0.f, 0.f};
    z = __builtin_amdgcn_mfma_f32_16x16x32_bf16(k0, q0, z, 0, 0, 0);
    z = __builtin_amdgcn_mfma_f32_16x16x32_bf16(k1, q1, z, 0, 0, 0);
    S[kt] = z;
    if ((kt & 3) == 3) __builtin_amdgcn_sched_barrier(0);
  }
  float mx = -3e38f;
#pragma unroll
  for (int kt = 0; kt < 16; ++kt)
#pragma unroll
    for (int r = 0; r < 4; ++r) {
      float s = S[kt][r] * (0.125f * 1.44269504f);
      if (OWN) { if (kt * 16 + 4 * g + r > tloc) s = -3e38f; }
      S[kt][r] = s;
      mx = fmaxf(mx, s);
    }
  mx = fmaxf(mx, __shfl_xor(mx, 16));
  mx = fmaxf(mx, __shfl_xor(mx, 32));
  float l = 0.f;
#pragma unroll
  for (int kt = 0; kt < 16; ++kt)
#pragma unroll
    for (int r = 0; r < 4; ++r) {
      float pv = __builtin_amdgcn_exp2f(S[kt][r] - mx);
      S[kt][r] = pv;
      l += pv;
    }
  l += __shfl_xor(l, 16);
  l += __shfl_xor(l, 32);
#pragma unroll
  for (int dt = 0; dt < 4; ++dt) O[dt] = (f32x4){0.f, 0.f, 0.f, 0.f};
  const unsigned char* vb = smem + 32768;
#pragma unroll
  for (int j = 0; j < 8; ++j) {
    union { bf16x8 v; unsigned u[4]; } pf;
    pf.u[0] = pack2(S[2 * j][0], S[2 * j][1]);
    pf.u[1] = pack2(S[2 * j][2], S[2 * j][3]);
    pf.u[2] = pack2(S[2 * j + 1][0], S[2 * j + 1][1]);
    pf.u[3] = pack2(S[2 * j + 1][2], S[2 * j + 1][3]);
#pragma unroll
    for (int dt = 0; dt < 4; ++dt) {
      const unsigned char* vp = vb + (dt * 16 + c16) * VT_LD + (32 * j + 4 * g) * 2;
      union { bf16x8 v; uint2 h[2]; } vf;
      vf.h[0] = *(const uint2*)(vp);
      vf.h[1] = *(const uint2*)(vp + 32);
      O[dt] = __builtin_amdgcn_mfma_f32_16x16x32_bf16(vf.v, pf.v, O[dt], 0, 0, 0);
    }
    if (j & 1) __builtin_amdgcn_sched_barrier(0);
  }
  mout = mx * 0.69314718f; lout = l;
}

__device__ __forceinline__ u16* part_ptr(const Params& p, int slot) {
  return (u16*)(p.ws + (slot == 0 ? SLOT(0) : slot == 1 ? SLOT(3) : SLOT(6)));
}

struct AItem { int li, seg, b, h, n, c; };

template <bool OWN>
__device__ __forceinline__ void phase_attn(const Params& p, unsigned char* smem) {
  const int tid = threadIdx.x, lane = tid & 63, w = tid >> 6, g = lane >> 4, c16 = lane & 15;
  const int G = gridDim.x;
  const int* cnt = (const int*)(p.ws + OFF_CNT);
  const u16* lists = (const u16*)(p.ws + SLOT(5));
  u16* Q = (u16*)(p.ws + SLOT(4));
  float* lse = (float*)(p.ws + OFF_LSE);
  int* offs = (int*)(smem + 66560);
  unsigned char* Qs = smem + 75008;
  unsigned* entl = (unsigned*)(smem + 75008 + 16384);
  int total = 4096;
  if (!OWN) {
    int* part = (int*)smem;
    int loc[4]; int s = 0;
#pragma unroll
    for (int i = 0; i < 4; ++i) { loc[i] = (cnt[tid * 4 + i] + 127) >> 7; s += loc[i]; }
    part[tid] = s;
    __syncthreads();
    if (tid == 0) { int a = 0; for (int i = 0; i < NT; ++i) { int v = part[i]; part[i] = a; a += v; } offs[2048] = a; }
    __syncthreads();
    int a = part[tid];
#pragma unroll
    for (int i = 0; i < 4; ++i) { offs[tid * 4 + i] = a; a += loc[i]; }
    __syncthreads();
    total = offs[2048];
  }
  if ((int)blockIdx.x >= total) return;
  const int J = (total - 1 - (int)blockIdx.x) / G + 1;
  int* itab = (int*)(smem + 75008 + 16384 + 512);
  int* ctab = itab + 1024;
  if (!OWN) {
    for (int j = tid; j < J; j += NT) {
      const int it_ = blockIdx.x + j * G;
      int lo = 0, hi = 2048;
      while (hi - lo > 1) { int mid = (lo + hi) >> 1; if (offs[mid] <= it_) lo = mid; else hi = mid; }
      itab[j] = lo | ((it_ - offs[lo]) << 11);
      ctab[j] = cnt[lo];
    }
    __syncthreads();
  }

  auto decode = [&](int j) {
    AItem d;
    if (OWN) { const int it = blockIdx.x + j * G; d.li = it >> 1; d.seg = it & 1; d.c = 0; }
    else {
      const int pk = itab[j];
      d.li = pk & 2047; d.seg = pk >> 11; d.c = ctab[j];
    }
    const int bh = d.li >> 5;
    d.n = d.li & 31; d.b = bh >> 4; d.h = bh & 15;
    return d;
  };
  auto load_ent1 = [&](const AItem& d, const int i) -> unsigned {
    const int row = (tid >> 3) + 64 * i;
    if (OWN) return (unsigned)(d.n * 256 + d.seg * 128 + row) | 0x8000u;
    const int qi = d.seg * 128 + row;
    const int qc = min(qi, 8191);
    unsigned v = lists[(size_t)d.li * 8192 + qc];
    return (qi < d.c) ? (v | 0x8000u) : 0u;
  };
  uint4 kr0, kr1, kr2, kr3, vr0, vr1, vr2, vr3, qr0, qr1;
  auto load_kvq = [&](const AItem& d, const unsigned e0, const unsigned e1) {
    const u16* Kb = (const u16*)(p.ws + SLOT(1)) + ((size_t)d.b * TT + d.n * 256) * DM + d.h * 64;
    const u16* Vt = (const u16*)(p.ws + SLOT(2)) + (size_t)(((d.b * 16 + d.h) * 32 + d.n) * 64) * 256;
#define LDKV(i, K_, V_) { const int idx = tid + NT * (i); K_ = *(const uint4*)(Kb + (size_t)(idx >> 3) * DM + (idx & 7) * 8); V_ = *(const uint4*)(Vt + (size_t)idx * 8); }
    LDKV(0, kr0, vr0) LDKV(1, kr1, vr1) LDKV(2, kr2, vr2) LDKV(3, kr3, vr3)
#undef LDKV
    qr0 = *(const uint4*)(Q + ((size_t)d.b * TT + (e0 & 8191u)) * DM + d.h * 64 + (tid & 7) * 8);
    qr1 = *(const uint4*)(Q + ((size_t)d.b * TT + (e1 & 8191u)) * DM + d.h * 64 + (tid & 7) * 8);
  };
  auto store_lds = [&](const unsigned e0, const unsigned e1) {
#define STKV(i, K_, V_) { const int idx = tid + NT * (i); *(uint4*)(smem + swz(idx >> 3, idx & 7)) = K_; *(uint4*)(smem + 32768 + (idx >> 5) * VT_LD + (idx & 31) * 16) = V_; }
    STKV(0, kr0, vr0) STKV(1, kr1, vr1) STKV(2, kr2, vr2) STKV(3, kr3, vr3)
#undef STKV
    *(uint4*)(Qs + swz(tid >> 3, tid & 7)) = qr0;
    *(uint4*)(Qs + swz((tid >> 3) + 64, tid & 7)) = qr1;
    if ((tid & 7) == 0) { entl[tid >> 3] = e0; entl[(tid >> 3) + 64] = e1; }
  };

  int it = 0;
  AItem dc = decode(0);
  unsigned ec0 = load_ent1(dc, 0), ec1 = load_ent1(dc, 1);
  load_kvq(dc, ec0, ec1);
  int itn = min(1, J - 1);
  AItem dn = decode(itn);
  unsigned en0 = load_ent1(dn, 0), en1 = load_ent1(dn, 1);
  while (true) {
    __syncthreads();
    store_lds(ec0, ec1);
    __syncthreads();
    load_kvq(dn, en0, en1);
    ec0 = en0; ec1 = en1;
    const AItem d = dc;
    dc = dn;
    itn = min(itn + 1, J - 1);
    dn = decode(itn);
    en0 = load_ent1(dn, 0); en1 = load_ent1(dn, 1);
    {
      const int row = w * 16 + c16;
      const unsigned ent = entl[row];
      const bool valid = (ent >> 15) != 0;
      const int t = ent & 8191, slot = (ent >> 13) & 3;
      const size_t m = (size_t)d.b * TT + t;
      const bf16x8 q0 = *(const bf16x8*)(Qs + swz(row, g));
      const bf16x8 q1 = *(const bf16x8*)(Qs + swz(row, g + 4));
      float mx, l; f32x4 O[4];
      attn_tile<OWN>(q0, q1, d.seg * 128 + row, smem, mx, l, O);
      if (!OWN) {
        if (valid) {
          const float inv = frcp_(l);
          u16* po = part_ptr(p, slot) + m * DM + d.h * 64;
#pragma unroll
          for (int dt = 0; dt < 4; ++dt) {
            uint2 o;
            o.x = pack2(O[dt][0] * inv, O[dt][1] * inv);
            o.y = pack2(O[dt][2] * inv, O[dt][3] * inv);
            *(uint2*)(po + dt * 16 + 4 * g) = o;
          }
          if (g == 0) lse[(size_t)slot * MT * 16 + m * 16 + d.h] = mx + __logf(l);
        }
      } else {
        float ls[3], M2 = mx;
#pragma unroll
        for (int s = 0; s < 3; ++s) { ls[s] = lse[(size_t)s * MT * 16 + m * 16 + d.h]; M2 = fmaxf(M2, ls[s]); }
        const float wo = __expf(mx - M2);
        float ws[3], den = l * wo;
#pragma unroll
        for (int s = 0; s < 3; ++s) { ws[s] = (ls[s] > -1e29f) ? __expf(ls[s] - M2) : 0.f; den += ws[s]; }
        const float inv = frcp_(den);
#pragma unroll
        for (int dt = 0; dt < 4; ++dt) {
          float o0 = O[dt][0] * wo, o1 = O[dt][1] * wo, o2 = O[dt][2] * wo, o3 = O[dt][3] * wo;
#pragma unroll
          for (int s = 0; s < 3; ++s) {
            if (ws[s] != 0.f) {
              const u16* pp = part_ptr(p, s) + m * DM + d.h * 64 + dt * 16 + 4 * g;
              uint2 u = *(const uint2*)pp;
              o0 += ws[s] * bflo(u.x); o1 += ws[s] * bfhi(u.x); o2 += ws[s] * bflo(u.y); o3 += ws[s] * bfhi(u.y);
            }
          }
          uint2 o;
          o.x = pack2(o0 * inv, o1 * inv);
          o.y = pack2(o2 * inv, o3 * inv);
          *(uint2*)(Q + m * DM + d.h * 64 + dt * 16 + 4 * g) = o;
        }
      }
    }
    it += 1;
    if (it >= J) break;
  }
}

#define TILE_LOOP(total) for (int _i = blockIdx.x, _G = gridDim.x, _tot = (total), _end = ((_tot + _G - 1) / _G) * _G; _i < _end; _i += _G)

#define EB(x) (1 << (x))
__device__ __forceinline__ void phase_rkv(const Params& p, unsigned char* smem) {
  const u16* wt = (const u16*)p.ws;
  TILE_LOOP(1536) {
    const int tile = tile_remap(_i);
    if (tile >= 1536) continue;
    const int s = tile >> 9, rem = tile & 511, mt = rem >> 2, nt = rem & 3;
    Epi e{};
    e.o16 = (s == 0) ? (u16*)(p.ws + SLOT(6)) : (u16*)DSLOT(p, s - 1); e.ldo = DM;
    gemm_tile<EB(EPI_BF16)>((const u16*)(p.ws + SLOT(s)), wt + WT_RKV + (size_t)s * M1, DM, mt * 256, nt * 256, EPI_BF16, e, smem);
  }
}

__device__ __forceinline__ void phase_lora1(const Params& p, unsigned char* smem) {
  const u16* wt = (const u16*)p.ws;
  u16* lora = (u16*)(p.ws + SLOT(0));
  TILE_LOOP(384) {
    const int tile = _i;
    if (tile >= 384) continue;
    const int j = tile >> 7, mt = tile & 127;
    Epi e{};
    e.o16 = lora + (size_t)j * MT * 256; e.ldo = 256;
    const u16* A = (const u16*)(p.ws + SLOT(3 + j));
    const u16* B = wt + WT_W1 + (size_t)j * 256 * 1024;
    const int epi = (j == 0) ? EPI_TANH : (j == 1) ? EPI_BF16 : EPI_SIG;
    gemm_tile<EB(EPI_TANH) | EB(EPI_BF16) | EB(EPI_SIG)>(A, B, DM, mt * 256, 0, epi, e, smem);
  }
}

__device__ __forceinline__ void phase_lora2(const Params& p, unsigned char* smem) {
  const u16* wt = (const u16*)p.ws;
  const u16* lora = (const u16*)(p.ws + SLOT(0));
  TILE_LOOP(1536) {
    const int tile = tile_remap(_i);
    if (tile >= 1536) continue;
    const int which = tile >> 9, rem = tile & 511, mt = rem >> 2, nt = rem & 3;
    Epi e{};
    e.o32 = (float*)(p.ws + SLOT(1));
    e.v0 = (which == 0) ? p.in[7] : p.in[10]; e.v1 = p.in[15]; e.v2 = p.in[16];
    e.kbuf = (u16*)DSLOT(p, 0); e.kkbuf = (u16*)(p.ws + SLOT(3)); e.abbuf = (u16*)(p.ws + SLOT(4));
    e.o16 = (u16*)(p.ws + SLOT(5)); e.ldo = DM;
    const int epi = (which == 0) ? EPI_DECAY : (which == 1) ? EPI_AK : EPI_BF16;
    gemm_tile<EB(EPI_DECAY) | EB(EPI_AK) | EB(EPI_BF16)>(lora + (size_t)which * MT * 256, wt + WT_W2 + (size_t)which * 256 * 1024, 256,
                                                        mt * 256, nt * 256, epi, e, smem);
  }
}

__device__ __forceinline__ void phase_resid(const Params& p, const u16* A, int K, const u16* Bt, const float* res, float* out, int gate_off, unsigned char* smem) {
  const float* mod = (const float*)(p.ws + OFF_MOD);
  TILE_LOOP(512) {
    const int tile = tile_remap(_i);
    if (tile >= 512) continue;
    const int mt = tile >> 2, nt = tile & 3;
    Epi e{};
    e.o32 = out; e.res = res; e.gate = mod + gate_off;
    gemm_tile<EB(EPI_RESID)>(A, Bt, K, mt * 256, nt * 256, EPI_RESID, e, smem);
  }
}

__device__ __forceinline__ void ffn_up_coords(int i, int& mt2, int& nt2) {
  const int tile = tile_remap(i);
  const int st = tile >> 5, w = tile & 31;
  if (st < 80) { mt2 = (st / 5) * 8 + (w >> 2); nt2 = (st % 5) * 4 + (w & 3); }
  else { mt2 = (st - 80) * 16 + (w >> 1); nt2 = 20 + (w & 1); }
}
__device__ __forceinline__ void phase_ffn_up(const Params& p, const u16* A, const u16* Bt, u16* act, unsigned char* smem) {
  const int G = gridDim.x, total = 128 * 22;
  for (int i = blockIdx.x; i < total; i += G) {
    int mt2, nt2, mtn = 0, ntn = 0;
    ffn_up_coords(i, mt2, nt2);
    const bool has_next = (i + G) < total;
    if (has_next) ffn_up_coords(i + G, mtn, ntn);
    Epi e{};
    e.o16 = act;
    gemm_tile<EB(EPI_SWIGLU), true>(A, Bt, DM, mt2 * 256, nt2 * 256, EPI_SWIGLU, e, smem,
                                    i == (int)blockIdx.x, has_next, mtn * 256, ntn * 256);
  }
  __syncthreads();
}

__device__ __forceinline__ void phase_qkv(const Params& p, unsigned char* smem) {
  const u16* wt = (const u16*)p.ws;
  TILE_LOOP(1536) {
    const int tile = tile_remap(_i);
    if (tile >= 1536) continue;
    const int which = tile >> 9, rem = tile & 511, mt = rem >> 2, nt = rem & 3;
    Epi e{};
    e.o16 = (u16*)(p.ws + (which == 0 ? SLOT(1) : which == 1 ? SLOT(2) : SLOT(4)));
    e.v0 = (which == 0) ? p.in[29] : p.in[31];
    const u16* A = (const u16*)(p.ws + (which == 2 ? SLOT(3) : SLOT(0)));
    const u16* B = wt + WT_KVK + (size_t)which * M1;
    const int epi = (which == 1) ? EPI_VT : EPI_HEADNORM;
    gemm_tile<EB(EPI_HEADNORM) | EB(EPI_VT)>(A, B, DM, mt * 256, nt * 256, epi, e, smem);
  }
}

constexpr int NPHASES = 21;
#ifdef ONLY_PHASE
#define PEN(k) ((k) == ONLY_PHASE)
#else
#define PEN(k) true
#endif
#define RUN(k, call) if (ph0 <= (k) && (k) < ph1) { if (PEN(k)) { call; } if ((k) + 1 < ph1) grid.sync(); }

__global__ void __launch_bounds__(512, 2) mega(Params p, int ph0, int ph1) {
  __shared__ __attribute__((aligned(16))) unsigned char smem[SMEM_BYTES];
  cg::grid_group grid = cg::this_grid();
  const float* mod = (const float*)(p.ws + OFF_MOD);
  const u16* wt = (const u16*)p.ws;
  RUN(0, phase_prep(p, smem))
  RUN(1, phase_norm_xs(p))
  RUN(2, phase_rkv(p, smem))
  RUN(3, phase_lora1(p, smem))
  RUN(4, phase_lora2(p, smem))
  RUN(5, phase_scan(p, smem))
  RUN(6, phase_gn(p))
  RUN(7, phase_resid(p, (const u16*)(p.ws + SLOT(0)), DM, wt + WT_WO, p.in[0], (float*)(p.ws + SLOT(1)), 2048, smem))
  RUN(8, phase_norm((const float*)(p.ws + SLOT(1)), p.in[2] + 1024, mod, 3072, 3072 + 1024, (u16*)(p.ws + SLOT(3)), nullptr, 0, 0, nullptr))
  RUN(9, phase_ffn_up(p, (const u16*)(p.ws + SLOT(3)), wt + WT_GU, (u16*)(p.ws + SLOT(4)), smem))
  RUN(10, phase_resid(p, (const u16*)(p.ws + SLOT(4)), FF, wt + WT_DN, (const float*)(p.ws + SLOT(1)), p.out, 3072 + 2048, smem))
  RUN(11, phase_norm(p.out, p.in[24], mod, 12288, 12288 + 1024, (u16*)(p.ws + SLOT(0)), p.in[2] + 2048, 6144, 6144 + 1024, (u16*)(p.ws + SLOT(3))))
  RUN(12, phase_qkv(p, smem))
  RUN(13, phase_kmean(p))
  RUN(14, phase_gate(p))
  RUN(15, phase_attn<false>(p, smem))
  RUN(16, phase_attn<true>(p, smem))
  RUN(17, phase_resid(p, (const u16*)(p.ws + SLOT(4)), DM, wt + WT_MBO, p.out, p.out, 6144 + 2048, smem))
  RUN(18, phase_norm(p.out, p.in[2] + 3072, mod, 9216, 9216 + 1024, (u16*)(p.ws + SLOT(0)), nullptr, 0, 0, nullptr))
  RUN(19, phase_ffn_up(p, (const u16*)(p.ws + SLOT(0)), wt + WT_GU + (size_t)5632 * 1024, (u16*)(p.ws + SLOT(1)), smem))
  RUN(20, phase_resid(p, (const u16*)(p.ws + SLOT(1)), FF, wt + WT_DN + (size_t)1024 * 2816, p.out, p.out, 9216 + 2048, smem))
}

extern "C" void kernel_launch(void* const* d_in, const int* in_sizes, int n_in, void* d_out, int out_size,
                              void* d_ws, size_t ws_size, hipStream_t stream) {
  static int grid_blocks = 0;
  if (!grid_blocks) {
    int dev = 0, cus = 0, per_cu = 0;
    (void)hipGetDevice(&dev);
    (void)hipDeviceGetAttribute(&cus, hipDeviceAttributeMultiprocessorCount, dev);
    (void)hipOccupancyMaxActiveBlocksPerMultiprocessor(&per_cu, mega, NT, 0);
    if (per_cu < 1) per_cu = 1;
    grid_blocks = cus;
    if (grid_blocks > cus * per_cu) grid_blocks = cus * per_cu;
    grid_blocks &= ~7;
  }
  Params p{};
  for (int i = 0; i < 33; ++i) p.in[i] = (const float*)d_in[i];
  p.out = (float*)d_out;
  p.ws = (unsigned char*)d_ws;
#if SINGLE_LAUNCH
  int ph0 = 0, ph1 = NPHASES;
  void* args[] = {&p, &ph0, &ph1};
  hipError_t e = hipLaunchCooperativeKernel((void*)mega, dim3(grid_blocks), dim3(NT), args, 0, stream);
  if (e != hipSuccess) fprintf(stderr, "cooperative launch failed: %s (grid %d)\n", hipGetErrorString(e), grid_blocks);
#else
  for (int ph = 0; ph < NPHASES; ++ph) mega<<<grid_blocks, NT, 0, stream>>>(p, ph, ph + 1);
#endif
}
```

```cpp
#include <hip/hip_runtime.h>
#include <hip/hip_cooperative_groups.h>
#include <cstdio>
namespace cg = cooperative_groups;

typedef unsigned short u16;
typedef __attribute__((ext_vector_type(8))) short bf16x8;
typedef __attribute__((ext_vector_type(4))) float f32x4;

#ifndef SINGLE_LAUNCH
#define SINGLE_LAUNCH 1
#endif

constexpr int NT = 512;
constexpr int NWV = 8;
constexpr int DM = 1024, NB = 4, TT = 8192, MT = NB * TT, FF = 2816, NH = 16;
constexpr int MODLD = 14336;
constexpr size_t MiB = 1u << 20;
constexpr size_t M1 = 1048576;

constexpr size_t WT_RKV = 0;
constexpr size_t WT_W1 = WT_RKV + 3 * M1;
constexpr size_t WT_A1 = WT_W1 + 256 * 1024;
constexpr size_t WT_G1 = WT_A1 + 256 * 1024;
constexpr size_t WT_W2 = WT_G1 + 256 * 1024;
constexpr size_t WT_A2 = WT_W2 + 256 * 1024;
constexpr size_t WT_G2 = WT_A2 + 256 * 1024;
constexpr size_t WT_WO = WT_G2 + 256 * 1024;
constexpr size_t WT_GU = WT_WO + M1;
constexpr size_t WT_DN = WT_GU + 2 * 5632 * 1024;
constexpr size_t WT_KVK = WT_DN + 2 * 1024 * 2816;
constexpr size_t WT_KVV = WT_KVK + M1;
constexpr size_t WT_Q = WT_KVV + M1;
constexpr size_t WT_MBO = WT_Q + M1;
constexpr size_t WT_END = WT_MBO + M1;
static_assert(WT_END * 2 <= 52 * MiB, "wt region");
constexpr size_t OFF_MOD = 52 * MiB;
constexpr size_t OFF_CNT = OFF_MOD + 4 * MODLD * 4;
constexpr size_t OFF_KMEAN = OFF_CNT + 2048 * 4;
constexpr size_t OFF_LSE = 53 * MiB;
constexpr size_t OFF_SLOT0 = 64 * MiB;
#define SLOT(i) (OFF_SLOT0 + (size_t)(i) * 64 * MiB)
#define DSLOT(p, i) ((unsigned char*)(p).out + (size_t)(i) * 64 * MiB)

constexpr int STG_LD = 132;
constexpr int STG_BYTES = 128 * STG_LD * 4;
constexpr int SMEM_BYTES = 2 * STG_BYTES + 256;

struct Params {
  const float* in[33];
  float* out;
  unsigned char* ws;
};

typedef __bf16 bf2v __attribute__((ext_vector_type(2)));
typedef float f2v __attribute__((ext_vector_type(2)));
__device__ __forceinline__ unsigned pack2(float a, float b) {
  f2v f = {a, b};
  bf2v r = __builtin_convertvector(f, bf2v);
  return __builtin_bit_cast(unsigned, r);
}
__device__ __forceinline__ u16 f2bf(float f) { return (u16)(pack2(f, 0.f) & 0xffffu); }
__device__ __forceinline__ float bf2f(u16 h) { return __uint_as_float(((unsigned)h) << 16); }
__device__ __forceinline__ float bflo(unsigned x) { return __uint_as_float(x << 16); }
__device__ __forceinline__ float bfhi(unsigned x) { return __uint_as_float(x & 0xffff0000u); }
__device__ __forceinline__ float frcp_(float x) { return __builtin_amdgcn_rcpf(x); }
__device__ __forceinline__ float sigmoidf_(float x) { return frcp_(1.f + __expf(-x)); }
__device__ __forceinline__ float siluf_(float x) { return x * frcp_(1.f + __expf(-x)); }
__device__ __forceinline__ float tanhf_(float x) { return 1.f - 2.f * frcp_(1.f + __expf(2.f * x)); }

template <int CTRL>
__device__ __forceinline__ float dppf(float x) {
  return __int_as_float(__builtin_amdgcn_update_dpp(0, __float_as_int(x), CTRL, 0xF, 0xF, true));
}
__device__ __forceinline__ float allreduce16(float x) {
  x += dppf<0xB1>(x);
  x += dppf<0x4E>(x);
  x += dppf<0x124>(x);
  x += dppf<0x128>(x);
  return x;
}
__device__ __forceinline__ float wave_sum(float x) {
#pragma unroll
  for (int o = 32; o >= 1; o >>= 1) x += __shfl_xor(x, o);
  return x;
}

__device__ __forceinline__ void unpack8(uint4 u, float* f) {
  f[0] = bflo(u.x); f[1] = bfhi(u.x); f[2] = bflo(u.y); f[3] = bfhi(u.y);
  f[4] = bflo(u.z); f[5] = bfhi(u.z); f[6] = bflo(u.w); f[7] = bfhi(u.w);
}
__device__ __forceinline__ uint4 pack8(const float* f) {
  uint4 o; o.x = pack2(f[0], f[1]); o.y = pack2(f[2], f[3]); o.z = pack2(f[4], f[5]); o.w = pack2(f[6], f[7]); return o;
}

struct TJob { const float* src; u16* dst; int K, N, Kp, Np, mode, which; };

__device__ __forceinline__ TJob get_job(const Params& p, int j) {
  u16* wt = (u16*)p.ws;
  TJob t;
  t.mode = 0; t.which = 0;
  switch (j) {
    case 0: t.src = p.in[6]; t.dst = wt + WT_RKV; t.K = 1024; t.N = 1024; t.Kp = 1024; t.Np = 1024; break;
    case 1: t.src = p.in[6] + M1; t.dst = wt + WT_RKV + M1; t.K = 1024; t.N = 1024; t.Kp = 1024; t.Np = 1024; break;
    case 2: t.src = p.in[6] + 2 * M1; t.dst = wt + WT_RKV + 2 * M1; t.K = 1024; t.N = 1024; t.Kp = 1024; t.Np = 1024; break;
    case 3: t.src = p.in[8]; t.dst = wt + WT_W1; t.K = 1024; t.N = 64; t.Kp = 1024; t.Np = 256; break;
    case 4: t.src = p.in[11]; t.dst = wt + WT_A1; t.K = 1024; t.N = 64; t.Kp = 1024; t.Np = 256; break;
    case 5: t.src = p.in[13]; t.dst = wt + WT_G1; t.K = 1024; t.N = 160; t.Kp = 1024; t.Np = 256; break;
    case 6: t.src = p.in[9]; t.dst = wt + WT_W2; t.K = 64; t.N = 1024; t.Kp = 256; t.Np = 1024; break;
    case 7: t.src = p.in[12]; t.dst = wt + WT_A2; t.K = 64; t.N = 1024; t.Kp = 256; t.Np = 1024; break;
    case 8: t.src = p.in[14]; t.dst = wt + WT_G2; t.K = 160; t.N = 1024; t.Kp = 256; t.Np = 1024; break;
    case 9: t.src = p.in[20]; t.dst = wt + WT_WO; t.K = 1024; t.N = 1024; t.Kp = 1024; t.Np = 1024; break;
    case 10: t.src = p.in[21]; t.dst = wt + WT_GU; t.K = 1024; t.N = 2816; t.Kp = 1024; t.Np = 2816; t.mode = 1; t.which = 0; break;
    case 11: t.src = p.in[22]; t.dst = wt + WT_GU; t.K = 1024; t.N = 2816; t.Kp = 1024; t.Np = 2816; t.mode = 1; t.which = 1; break;
    case 12: t.src = p.in[21] + (size_t)1024 * 2816; t.dst = wt + WT_GU + (size_t)5632 * 1024; t.K = 1024; t.N = 2816; t.Kp = 1024; t.Np = 2816; t.mode = 1; t.which = 0; break;
    case 13: t.src = p.in[22] + (size_t)1024 * 2816; t.dst = wt + WT_GU + (size_t)5632 * 1024; t.K = 1024; t.N = 2816; t.Kp = 1024; t.Np = 2816; t.mode = 1; t.which = 1; break;
    case 14: t.src = p.in[23]; t.dst = wt + WT_DN; t.K = 2816; t.N = 1024; t.Kp = 2816; t.Np = 1024; break;
    case 15: t.src = p.in[23] + (size_t)1024 * 2816; t.dst = wt + WT_DN + (size_t)1024 * 2816; t.K = 2816; t.N = 1024; t.Kp = 2816; t.Np = 1024; break;
    case 16: t.src = p.in[27]; t.dst = wt + WT_KVK; t.K = 1024; t.N = 1024; t.Kp = 1024; t.Np = 1024; break;
    case 17: t.src = p.in[28]; t.dst = wt + WT_KVV; t.K = 1024; t.N = 1024; t.Kp = 1024; t.Np = 1024; break;
    case 18: t.src = p.in[30]; t.dst = wt + WT_Q; t.K = 1024; t.N = 1024; t.Kp = 1024; t.Np = 1024; break;
    default: t.src = p.in[32]; t.dst = wt + WT_MBO; t.K = 1024; t.N = 1024; t.Kp = 1024; t.Np = 1024; break;
  }
  return t;
}
constexpr int NJOBS = 20;

__device__ __forceinline__ void phase_prep(const Params& p, unsigned char* smem) {
  const int tid = threadIdx.x;
  if (blockIdx.x == 0) {
    int* cnt = (int*)(p.ws + OFF_CNT);
    for (int i = tid; i < 2048; i += NT) cnt[i] = 0;
  }
  int total = 0;
  for (int j = 0; j < NJOBS; ++j) { TJob t = get_job(p, j); total += (t.Np >> 6) * (t.Kp >> 6); }
  float (*tile)[65] = (float (*)[65])smem;
  const int NADA = MODLD / 64;
  auto decode_tile = [&](int it_, TJob& t, int& n0, int& k0) {
    int j = 0, lt = it_;
    t = get_job(p, 0);
    while (true) {
      int n = (t.Np >> 6) * (t.Kp >> 6);
      if (lt < n) break;
      lt -= n; ++j; t = get_job(p, j);
    }
    const int nkt = t.Kp >> 6;
    n0 = (lt / nkt) * 64; k0 = (lt % nkt) * 64;
  };
  auto tile_load = [&](const TJob& t, int n0, int k0, float4& v0, float4& v1) {
    {
      const int kk = tid >> 4, n4 = (tid & 15) * 4;
      const int k = k0 + kk, n = n0 + n4;
      v0 = make_float4(0.f, 0.f, 0.f, 0.f);
      if (k < t.K && n < t.N) v0 = *(const float4*)(t.src + (size_t)k * t.N + n);
    }
    {
      const int kk = (tid + NT) >> 4, n4 = (tid & 15) * 4;
      const int k = k0 + kk, n = n0 + n4;
      v1 = make_float4(0.f, 0.f, 0.f, 0.f);
      if (k < t.K && n < t.N) v1 = *(const float4*)(t.src + (size_t)k * t.N + n);
    }
  };
  int it = blockIdx.x;
  {
    TJob t; int n0 = 0, k0 = 0; float4 v0, v1;
    if (it < total) { decode_tile(it, t, n0, k0); tile_load(t, n0, k0, v0, v1); }
    while (it < total) {
      {
        const int kk = tid >> 4, n4 = (tid & 15) * 4;
        tile[kk][n4] = v0.x; tile[kk][n4 + 1] = v0.y; tile[kk][n4 + 2] = v0.z; tile[kk][n4 + 3] = v0.w;
        tile[kk + 32][n4] = v1.x; tile[kk + 32][n4 + 1] = v1.y; tile[kk + 32][n4 + 2] = v1.z; tile[kk + 32][n4 + 3] = v1.w;
      }
      __syncthreads();
      const int itn = it + gridDim.x;
      TJob tn = t; int n0n = n0, k0n = k0;
      if (itn < total) { decode_tile(itn, tn, n0n, k0n); tile_load(tn, n0n, k0n, v0, v1); }
      {
        const int nn = tid >> 3, kk0 = (tid & 7) * 8;
        const int n = n0 + nn;
        const int drow = t.mode ? ((n >> 4) * 32 + t.which * 16 + (n & 15)) : n;
        float f[8];
#pragma unroll
        for (int q = 0; q < 8; ++q) f[q] = tile[kk0 + q][nn];
        *(uint4*)(t.dst + (size_t)drow * t.Kp + k0 + kk0) = pack8(f);
      }
      __syncthreads();
      t = tn; n0 = n0n; k0 = k0n; it = itn;
    }
  }
  for (; it < total + NADA; it += gridDim.x) {
    {
      const int a = it - total;
      const int ncol0 = a * 64;
      const float* W; const float* bias; int ldw, nl0;
      if (ncol0 < 12288) {
        int g = ncol0 / 3072;
        W = p.in[3] + (size_t)g * 1024 * 3072; bias = p.in[4] + g * 3072; ldw = 3072; nl0 = ncol0 - g * 3072;
      } else {
        W = p.in[25]; bias = p.in[26]; ldw = 2048; nl0 = ncol0 - 12288;
      }
      float* sc = (float*)smem;
      float* red = (float*)(smem + 16384);
      const float* c = p.in[1];
      for (int i = tid; i < 4096; i += NT) sc[i] = siluf_(c[i]);
      __syncthreads();
      const int w = tid >> 6, lane = tid & 63;
      float a0 = 0, a1 = 0, a2 = 0, a3 = 0;
      const float* wp = W + (size_t)(w * 128) * ldw + nl0 + lane;
#pragma unroll 8
      for (int k = 0; k < 128; ++k) {
        float wv = wp[(size_t)k * ldw];
        int kk = w * 128 + k;
        a0 += sc[kk] * wv; a1 += sc[1024 + kk] * wv; a2 += sc[2048 + kk] * wv; a3 += sc[3072 + kk] * wv;
      }
      red[(w * 4 + 0) * 64 + lane] = a0; red[(w * 4 + 1) * 64 + lane] = a1;
      red[(w * 4 + 2) * 64 + lane] = a2; red[(w * 4 + 3) * 64 + lane] = a3;
      __syncthreads();
      if (tid < 256) {
        int b = tid >> 6;
        float s = 0.f;
#pragma unroll
        for (int ww = 0; ww < 8; ++ww) s += red[(ww * 4 + b) * 64 + lane];
        float* mod = (float*)(p.ws + OFF_MOD);
        mod[b * MODLD + ncol0 + lane] = s + bias[nl0 + lane];
      }
      __syncthreads();
    }
  }
}

__device__ __forceinline__ void phase_norm(const u16* __restrict__ x, const float* __restrict__ g1, const float* __restrict__ mod,
                           int sh1, int sc1, u16* __restrict__ o1,
                           const float* __restrict__ g2, int sh2, int sc2, u16* __restrict__ o2) {
  const int lane = threadIdx.x & 63;
  const int gw = blockIdx.x * NWV + (threadIdx.x >> 6);
  const int nw = gridDim.x * NWV;
  for (int row = gw; row < MT; row += nw) {
    const uint2* xp = (const uint2*)(x + (size_t)row * DM);
    float4 v[4];
    float ss = 0.f;
#pragma unroll
    for (int i = 0; i < 4; ++i) {
      const uint2 t = xp[lane + 64 * i];
      v[i] = make_float4(bflo(t.x), bfhi(t.x), bflo(t.y), bfhi(t.y));
      ss += v[i].x * v[i].x + v[i].y * v[i].y + v[i].z * v[i].z + v[i].w * v[i].w;
    }
    ss = wave_sum(ss);
    const float rs = rsqrtf(ss * (1.f / DM) + 1e-6f);
    const int b = row >> 13;
    const float* mb = mod + (size_t)b * MODLD;
#pragma unroll
    for (int i = 0; i < 4; ++i) {
      const int c = (lane + 64 * i) * 4;
      float4 gg = *(const float4*)(g1 + c);
      float4 sh = *(const float4*)(mb + sh1 + c);
      float4 sc = *(const float4*)(mb + sc1 + c);
      uint2 o;
      o.x = pack2(v[i].x * rs * gg.x * (1.f + sc.x) + sh.x, v[i].y * rs * gg.y * (1.f + sc.y) + sh.y);
      o.y = pack2(v[i].z * rs * gg.z * (1.f + sc.z) + sh.z, v[i].w * rs * gg.w * (1.f + sc.w) + sh.w);
      *(uint2*)(o1 + (size_t)row * DM + c) = o;
      if (o2) {
        float4 gg2 = *(const float4*)(g2 + c);
        float4 sh_ = *(const float4*)(mb + sh2 + c);
        float4 sc_ = *(const float4*)(mb + sc2 + c);
        uint2 q;
        q.x = pack2(v[i].x * rs * gg2.x * (1.f + sc_.x) + sh_.x, v[i].y * rs * gg2.y * (1.f + sc_.y) + sh_.y);
        q.y = pack2(v[i].z * rs * gg2.z * (1.f + sc_.z) + sh_.z, v[i].w * rs * gg2.w * (1.f + sc_.w) + sh_.w);
        *(uint2*)(o2 + (size_t)row * DM + c) = q;
      }
    }
  }
}

__device__ __forceinline__ void phase_norm_xs(const Params& p) {
  const float* x = p.in[0];
  const float* g1 = p.in[2];
  const float* mod = (const float*)(p.ws + OFF_MOD);
  const float* mu = p.in[5];
  const int lane = threadIdx.x & 63;
  const int gw = blockIdx.x * NWV + (threadIdx.x >> 6);
  const int nw = gridDim.x * NWV;
  float muv[6][2][8];
#pragma unroll
  for (int ch = 0; ch < 2; ++ch) {
    const int col = (lane + 64 * ch) * 8;
#pragma unroll
    for (int s6 = 0; s6 < 6; ++s6) {
      float4 m0 = *(const float4*)(mu + s6 * DM + col), m1 = *(const float4*)(mu + s6 * DM + col + 4);
      muv[s6][ch][0] = m0.x; muv[s6][ch][1] = m0.y; muv[s6][ch][2] = m0.z; muv[s6][ch][3] = m0.w;
      muv[s6][ch][4] = m1.x; muv[s6][ch][5] = m1.y; muv[s6][ch][6] = m1.z; muv[s6][ch][7] = m1.w;
    }
  }
  auto ldrow = [&](int row, float4* v, float4* u) {
    const bool first = (row & (TT - 1)) == 0;
    const float* xp = x + (size_t)row * DM;
    const float* xq = x + (size_t)(first ? row : row - 1) * DM;
#pragma unroll
    for (int ch = 0; ch < 2; ++ch) {
      const int col = (lane + 64 * ch) * 8;
      v[2 * ch] = *(const float4*)(xp + col); v[2 * ch + 1] = *(const float4*)(xp + col + 4);
      u[2 * ch] = *(const float4*)(xq + col); u[2 * ch + 1] = *(const float4*)(xq + col + 4);
    }
  };
  float4 v[4], u[4];
  int row = gw;
  if (row < MT) ldrow(row, v, u);
  for (; row < MT; row += nw) {
    float4 vn[4], un[4];
    const int rn = row + nw;
    ldrow(rn < MT ? rn : row, vn, un);
    __builtin_amdgcn_sched_barrier(0);
    const bool first = (row & (TT - 1)) == 0;
    float ss = 0.f, st = 0.f;
#pragma unroll
    for (int i = 0; i < 4; ++i) {
      ss += v[i].x * v[i].x + v[i].y * v[i].y + v[i].z * v[i].z + v[i].w * v[i].w;
      st += u[i].x * u[i].x + u[i].y * u[i].y + u[i].z * u[i].z + u[i].w * u[i].w;
    }
    ss = wave_sum(ss); st = wave_sum(st);
    const float rs = rsqrtf(ss * (1.f / DM) + 1e-6f);
    const float rt = first ? 0.f : rsqrtf(st * (1.f / DM) + 1e-6f);
    const float* mb = mod + (size_t)(row >> 13) * MODLD;
#pragma unroll
    for (int ch = 0; ch < 2; ++ch) {
      const int col = (lane + 64 * ch) * 8;
      float4 sh0 = *(const float4*)(mb + col), sh1 = *(const float4*)(mb + col + 4);
      float4 sc0 = *(const float4*)(mb + 1024 + col), sc1 = *(const float4*)(mb + 1024 + col + 4);
      float4 gm0 = *(const float4*)(g1 + col), gm1 = *(const float4*)(g1 + col + 4);
      const float gmv[8] = {gm0.x, gm0.y, gm0.z, gm0.w, gm1.x, gm1.y, gm1.z, gm1.w};
      const float sh[8] = {sh0.x, sh0.y, sh0.z, sh0.w, sh1.x, sh1.y, sh1.z, sh1.w};
      const float sc[8] = {sc0.x, sc0.y, sc0.z, sc0.w, sc1.x, sc1.y, sc1.z, sc1.w};
      const float xv[8] = {v[2 * ch].x, v[2 * ch].y, v[2 * ch].z, v[2 * ch].w, v[2 * ch + 1].x, v[2 * ch + 1].y, v[2 * ch + 1].z, v[2 * ch + 1].w};
      const float uv[8] = {u[2 * ch].x, u[2 * ch].y, u[2 * ch].z, u[2 * ch].w, u[2 * ch + 1].x, u[2 * ch + 1].y, u[2 * ch + 1].z, u[2 * ch + 1].w};
      float h[8], d[8];
#pragma unroll
      for (int e = 0; e < 8; ++e) {
        const float gg = gmv[e] * (1.f + sc[e]);
        h[e] = xv[e] * rs * gg + sh[e];
        const float q = first ? 0.f : (uv[e] * rt * gg + sh[e]);
        d[e] = q - h[e];
      }
#pragma unroll
      for (int s6 = 0; s6 < 6; ++s6) {
        float o[8];
#pragma unroll
        for (int e = 0; e < 8; ++e) o[e] = h[e] + d[e] * muv[s6][ch][e];
        *(uint4*)((u16*)(p.ws + SLOT(s6)) + (size_t)row * DM + col) = pack8(o);
      }
    }
#pragma unroll
    for (int i = 0; i < 4; ++i) { v[i] = vn[i]; u[i] = un[i]; }
  }
}

enum { EPI_BF16 = 0, EPI_TANH, EPI_SIG, EPI_DECAY, EPI_AK, EPI_RESID, EPI_SWIGLU, EPI_HEADNORM, EPI_VT };
struct Epi {
  u16* o16; float* o32; const float* res; const float* gate; int ldo;
  const float* v0; const float* v1; const float* v2;
  u16* kbuf; u16* kkbuf; u16* abbuf;
};

constexpr int G_BK = 64, G_HALF = 128, G_HT = G_HALF * G_BK;

__device__ __forceinline__ int lds_byte(int r, int c) {
  int st = (r >> 4) * 2 + (c >> 5), rr = r & 15, cc = c & 31, ob = rr * 64 + cc * 2;
  return st * 1024 + (ob ^ (((ob >> 9) & 1) << 5));
}
__device__ __forceinline__ void stage_rc(int b, int& R, int& C) {
  int st = b / 1024, sb = b % 1024, swz = sb ^ (((sb >> 9) & 1) << 5);
  R = (st >> 1) * 16 + swz / 64; C = (st & 1) * 32 + (swz % 64) / 2;
}

#define IS(x) ((((EPISET) >> (x)) & 1) && epi == (x))
template <int EPISET>
__device__ __forceinline__ void gemm_tile(const u16* __restrict__ A, const u16* __restrict__ Bt, const int K,
                                          const int brow, const int bcol, const int epi, const Epi& e, unsigned char* smem) {
  u16* shm = (u16*)smem;
#define SA(b, h) (shm + ((b) * 2 + (h)) * G_HT)
#define SB(b, h) (shm + (4 + (b) * 2 + (h)) * G_HT)
#define STAGE(P, BASE, br, kt) do { const char* _gb = (const char*)((BASE) + (long)(br) * K + (long)(kt) * G_BK); \
      __builtin_amdgcn_global_load_lds((const unsigned*)(_gb + (size_t)voff), \
        (__attribute__((address_space(3))) unsigned*)((char*)(P) + threadIdx.x * 16), 16, 0, 0); \
      __builtin_amdgcn_global_load_lds((const unsigned*)(_gb + (size_t)K * 128 + (size_t)voff), \
        (__attribute__((address_space(3))) unsigned*)((char*)(P) + threadIdx.x * 16 + 8192), 16, 0, 0); } while (0)
#define LDA(dst, b, h) for (int m = 0; m < 4; ++m) for (int k = 0; k < 2; ++k) \
    dst[m][k] = *reinterpret_cast<const bf16x8*>((char*)SA(b, h) + lds_byte(wr * 64 + m * 16 + fr, k * 32 + fq * 8))
#define LDB(dst, b, h) for (int n = 0; n < 2; ++n) for (int k = 0; k < 2; ++k) \
    dst[n][k] = *reinterpret_cast<const bf16x8*>((char*)SB(b, h) + lds_byte(wc * 32 + n * 16 + fr, k * 32 + fq * 8))
#define MMA(ai, bj, At_, Bt_) do { __builtin_amdgcn_s_setprio(1); \
    for (int m = 0; m < 4; ++m) for (int n = 0; n < 2; ++n) for (int k = 0; k < 2; ++k) \
      acc[ai][bj][m][n] = __builtin_amdgcn_mfma_f32_16x16x32_bf16(At_[m][k], Bt_[n][k], acc[ai][bj][m][n], 0, 0, 0); \
    __builtin_amdgcn_s_setprio(0); } while (0)
#define WAIT_V(n) asm volatile("s_waitcnt vmcnt(" #n ")" ::: "memory")
#define WAIT_L(n) asm volatile("s_waitcnt lgkmcnt(" #n ")" ::: "memory")
#define BAR __builtin_amdgcn_s_barrier()
#define SCHED __builtin_amdgcn_sched_barrier(0)
  const int tid = threadIdx.x;
  const int wid = tid >> 6, lane = tid & 63, wr = wid >> 2, wc = wid & 3, fr = lane & 15, fq = lane >> 4;
  f32x4 acc[2][2][4][2] = {};
  bf16x8 At[4][2], B0[2][2], B1[2][2];
  int nt = K / G_BK;
  asm volatile("" : "+s"(nt));
  unsigned voff;
  { int _r, _c; stage_rc(tid * 16, _r, _c); voff = (unsigned)(_r * K + _c) * 2u; }
  __syncthreads();
  STAGE(SB(0, 0), Bt, bcol, 0); STAGE(SA(0, 0), A, brow, 0);
  STAGE(SB(0, 1), Bt, bcol + G_HALF, 0); STAGE(SA(0, 1), A, brow + G_HALF, 0);
  if (wr == 1) BAR;
  WAIT_V(4); BAR;
  STAGE(SB(1, 0), Bt, bcol, 1); STAGE(SA(1, 0), A, brow, 1); STAGE(SB(1, 1), Bt, bcol + G_HALF, 1);
  WAIT_V(6); BAR;
#pragma unroll 1
  for (int t = 0; t < nt - 2; t += 2) {
    LDB(B0, 0, 0); SCHED; LDA(At, 0, 0); STAGE(SA(1, 1), A, brow + G_HALF, t + 1);
    WAIT_L(8); BAR; WAIT_L(0); MMA(0, 0, At, B0); BAR; SCHED;
    LDB(B1, 0, 1); STAGE(SB(0, 0), Bt, bcol, t + 2);
    BAR; WAIT_L(0); MMA(0, 1, At, B1); BAR;
    LDA(At, 0, 1); STAGE(SA(0, 0), A, brow, t + 2);
    BAR; WAIT_L(0); MMA(1, 0, At, B0); BAR; SCHED;
    STAGE(SB(0, 1), Bt, bcol + G_HALF, t + 2);
    WAIT_V(6); BAR; MMA(1, 1, At, B1); BAR;
    LDB(B0, 1, 0); SCHED; LDA(At, 1, 0); STAGE(SA(0, 1), A, brow + G_HALF, t + 2);
    WAIT_L(8); BAR; WAIT_L(0); MMA(0, 0, At, B0); BAR; SCHED;
    LDB(B1, 1, 1); STAGE(SB(1, 0), Bt, bcol, t + 3);
    BAR; WAIT_L(0); MMA(0, 1, At, B1); BAR;
    LDA(At, 1, 1); STAGE(SA(1, 0), A, brow, t + 3);
    BAR; WAIT_L(0); MMA(1, 0, At, B0); BAR; SCHED;
    STAGE(SB(1, 1), Bt, bcol + G_HALF, t + 3);
    WAIT_V(6); BAR; MMA(1, 1, At, B1); BAR;
  }
  { LDB(B0, 0, 0); LDA(At, 0, 0); STAGE(SA(1, 1), A, brow + G_HALF, nt - 1);
    BAR; WAIT_L(0); MMA(0, 0, At, B0); BAR;
    LDB(B1, 0, 1); BAR; WAIT_L(0); MMA(0, 1, At, B1); BAR;
    LDA(At, 0, 1); WAIT_V(4); BAR; WAIT_L(0); MMA(1, 0, At, B0); MMA(1, 1, At, B1); BAR; }
  { LDB(B0, 1, 0); LDA(At, 1, 0); WAIT_V(2); BAR; WAIT_L(0); MMA(0, 0, At, B0); BAR;
    LDB(B1, 1, 1); WAIT_V(0); BAR; WAIT_L(0); MMA(0, 1, At, B1); BAR;
    LDA(At, 1, 1); BAR; WAIT_L(0); MMA(1, 0, At, B0); MMA(1, 1, At, B1); BAR; }
  if (wr == 0) BAR;
#undef SA
#undef SB
#undef STAGE
#undef LDA
#undef LDB
#undef MMA
#undef WAIT_V
#undef WAIT_L
#undef BAR
#undef SCHED

  int tid_e;
  asm volatile("v_mov_b32 %0, %1" : "=v"(tid_e) : "v"(tid));
  const int wid_e = tid_e >> 6, lane_e = tid_e & 63, wr_e = wid_e >> 2, wc_e = wid_e & 3, fr_e = lane_e & 15, fq_e = lane_e >> 4;
#pragma unroll
  for (int ai = 0; ai < 2; ++ai)
#pragma unroll
    for (int bj = 0; bj < 2; ++bj) {
      float* stg = (float*)(smem + ((ai * 2 + bj) & 1) * STG_BYTES);
      if (IS(EPI_VT)) {
#pragma unroll
        for (int m = 0; m < 4; ++m)
#pragma unroll
          for (int n = 0; n < 2; ++n) {
            f32x4 a4 = acc[ai][bj][m][n];
            *(float4*)(stg + (wc_e * 32 + n * 16 + fr_e) * STG_LD + wr_e * 64 + m * 16 + fq_e * 4) = make_float4(a4[0], a4[1], a4[2], a4[3]);
          }
      } else {
#pragma unroll
        for (int m = 0; m < 4; ++m)
#pragma unroll
          for (int n = 0; n < 2; ++n)
#pragma unroll
            for (int j = 0; j < 4; ++j)
              stg[(wr_e * 64 + m * 16 + fq_e * 4 + j) * STG_LD + wc_e * 32 + n * 16 + fr_e] = acc[ai][bj][m][n][j];
      }
      __syncthreads();
      const int r0 = brow + ai * 128, c0 = bcol + bj * 128;
      if (IS(EPI_SWIGLU)) {
#pragma unroll
        for (int i = 0; i < 2; ++i) {
          const int item = tid_e + NT * i;
          const int row = item >> 3, o0 = (item & 7) * 8;
          const int gc = (o0 >> 4) * 32 + (o0 & 15);
          const float* sp = stg + row * STG_LD + gc;
          float4 g0 = *(const float4*)(sp), g1 = *(const float4*)(sp + 4);
          float4 u0 = *(const float4*)(sp + 16), u1 = *(const float4*)(sp + 20);
          float o[8] = {siluf_(g0.x) * u0.x, siluf_(g0.y) * u0.y, siluf_(g0.z) * u0.z, siluf_(g0.w) * u0.w,
                        siluf_(g1.x) * u1.x, siluf_(g1.y) * u1.y, siluf_(g1.z) * u1.z, siluf_(g1.w) * u1.w};
          *(uint4*)(e.o16 + (size_t)(r0 + row) * FF + (c0 >> 1) + o0) = pack8(o);
        }
      } else if (IS(EPI_VT)) {
#pragma unroll 1
        for (int i = 0; i < 4; ++i) {
          const int item = tid_e + NT * i;
          const int kg = item & 15, dl = item >> 4;
          const float* sp = stg + dl * STG_LD + kg * 8;
          float4 a = *(const float4*)sp, b4 = *(const float4*)(sp + 4);
          float o[8] = {a.x, a.y, a.z, a.w, b4.x, b4.y, b4.z, b4.w};
          const int tok = r0 + kg * 8;
          const int b = tok >> 13, t = tok & (TT - 1), nblk = t >> 8, key = t & 255;
          const int col = c0 + dl, h = col >> 6, d = col & 63;
          *(uint4*)(e.o16 + ((size_t)(((b * 16 + h) * 32 + nblk) * 64 + d)) * 256 + key) = pack8(o);
        }
      } else {
#pragma unroll 1
        for (int i = 0; i < 4; ++i) {
          const int row = (tid_e >> 4) + 32 * i, cg = tid_e & 15;
          const float* sp = stg + row * STG_LD + cg * 8;
          float4 a = *(const float4*)sp, b4 = *(const float4*)(sp + 4);
          float v[8] = {a.x, a.y, a.z, a.w, b4.x, b4.y, b4.z, b4.w};
          const int grow = r0 + row, gcol = c0 + cg * 8;
          if (IS(EPI_BF16) || IS(EPI_TANH) || IS(EPI_SIG)) {
#pragma unroll
            for (int q = 0; q < 8; ++q) {
              if (IS(EPI_TANH)) v[q] = tanhf_(v[q]);
              if (IS(EPI_SIG)) v[q] = sigmoidf_(v[q]);
            }
            *(uint4*)(e.o16 + (size_t)grow * e.ldo + gcol) = pack8(v);
          } else if (IS(EPI_DECAY)) {
            float4 w0a = *(const float4*)(e.v0 + gcol), w0b = *(const float4*)(e.v0 + gcol + 4);
            float w0[8] = {w0a.x, w0a.y, w0a.z, w0a.w, w0b.x, w0b.y, w0b.z, w0b.w};
            float o[8];
#pragma unroll
            for (int q = 0; q < 8; ++q) {
              o[q] = __expf(-0.60653066f * sigmoidf_(w0[q] + v[q]));
            }
            float* op = e.o32 + (size_t)grow * DM + gcol;
            *(float4*)op = make_float4(o[0], o[1], o[2], o[3]);
            *(float4*)(op + 4) = make_float4(o[4], o[5], o[6], o[7]);
          } else if (IS(EPI_AK)) {
            const size_t off = (size_t)grow * DM + gcol;
            float kv[8]; unpack8(*(const uint4*)(e.kbuf + off), kv);
            float4 t0 = *(const float4*)(e.v0 + gcol), t1 = *(const float4*)(e.v0 + gcol + 4);
            float a0[8] = {t0.x, t0.y, t0.z, t0.w, t1.x, t1.y, t1.z, t1.w};
            t0 = *(const float4*)(e.v1 + gcol); t1 = *(const float4*)(e.v1 + gcol + 4);
            float kkc[8] = {t0.x, t0.y, t0.z, t0.w, t1.x, t1.y, t1.z, t1.w};
            t0 = *(const float4*)(e.v2 + gcol); t1 = *(const float4*)(e.v2 + gcol + 4);
            float kac[8] = {t0.x, t0.y, t0.z, t0.w, t1.x, t1.y, t1.z, t1.w};
            float kkv[8], ss = 0.f;
#pragma unroll
            for (int q = 0; q < 8; ++q) { kkv[q] = kv[q] * kkc[q]; ss += kkv[q] * kkv[q]; }
            ss += __shfl_xor(ss, 1); ss += __shfl_xor(ss, 2); ss += __shfl_xor(ss, 4);
            const float inv = fminf(__builtin_amdgcn_rsqf(ss), 1e12f);
            float o1[8], o2[8], o3[8];
#pragma unroll
            for (int q = 0; q < 8; ++q) {
              const float aa = sigmoidf_(a0[q] + v[q]);
              const float kkn = kkv[q] * inv;
              o1[q] = kv[q] * (1.f + (aa - 1.f) * kac[q]);
              o2[q] = kkn;
              o3[q] = kkn * aa;
            }
            *(uint4*)(e.kbuf + off) = pack8(o1);
            *(uint4*)(e.kkbuf + off) = pack8(o2);
            *(uint4*)(e.abbuf + off) = pack8(o3);
          } else if (IS(EPI_RESID)) {
            const size_t off = (size_t)grow * DM + gcol;
            const float* gp = e.gate + (size_t)(grow >> 13) * MODLD + gcol;
            float rv[8];
            if (e.res) {
              float4 r0v = *(const float4*)(e.res + off), r1v = *(const float4*)(e.res + off + 4);
              rv[0] = r0v.x; rv[1] = r0v.y; rv[2] = r0v.z; rv[3] = r0v.w; rv[4] = r1v.x; rv[5] = r1v.y; rv[6] = r1v.z; rv[7] = r1v.w;
            } else {
              unpack8(*(const uint4*)(e.kbuf + off), rv);
            }
            float4 g0 = *(const float4*)gp, g1 = *(const float4*)(gp + 4);
            const float gg[8] = {g0.x, g0.y, g0.z, g0.w, g1.x, g1.y, g1.z, g1.w};
            float o[8];
#pragma unroll
            for (int q = 0; q < 8; ++q) o[q] = rv[q] + gg[q] * v[q];
            if (e.o32) {
              *(float4*)(e.o32 + off) = make_float4(o[0], o[1], o[2], o[3]);
              *(float4*)(e.o32 + off + 4) = make_float4(o[4], o[5], o[6], o[7]);
            } else {
              *(uint4*)(e.o16 + off) = pack8(o);
            }
          } else if (IS(EPI_HEADNORM)) {
            float ss = 0.f;
#pragma unroll
            for (int q = 0; q < 8; ++q) ss += v[q] * v[q];
            ss += __shfl_xor(ss, 1); ss += __shfl_xor(ss, 2); ss += __shfl_xor(ss, 4);
            const float rs = rsqrtf(ss * (1.f / 64.f) + 1e-6f);
            float4 t0 = *(const float4*)(e.v0 + (gcol & 63)), t1 = *(const float4*)(e.v0 + (gcol & 63) + 4);
            float gn[8] = {t0.x, t0.y, t0.z, t0.w, t1.x, t1.y, t1.z, t1.w};
#pragma unroll
            for (int q = 0; q < 8; ++q) v[q] = v[q] * rs * gn[q];
            *(uint4*)(e.o16 + (size_t)grow * DM + gcol) = pack8(v);
          }
        }
      }
    }
}

__device__ __forceinline__ int tile_remap(int i) {
  const int G = gridDim.x;
  const int b = i % G, r = i / G;
  const int per = G >> 3;
  return r * G + (b & 7) * per + (b >> 3);
}

typedef float v2f __attribute__((ext_vector_type(2)));
constexpr int SC_TC = 16;
constexpr int SC_BUF = 5 * SC_TC * 64 * 4 + SC_TC * 16 * 4;
struct ScanRegs { uint4 a, b; float4 d; uint2 v; };

__device__ __forceinline__ void phase_scan(const Params& p, unsigned char* smem) {
  if (blockIdx.x >= 256) return;
  const int sb = blockIdx.x, bh = sb & 63, rg = sb >> 6;
  const int b = bh >> 4, h = bh & 15;
  const size_t base = (size_t)b * TT * DM + h * 64;
  const u16* Rb = (const u16*)(p.ws + SLOT(6));
  const u16* Kb = (const u16*)DSLOT(p, 0);
  const u16* Vb = (const u16*)DSLOT(p, 1);
  const u16* KKb = (const u16*)(p.ws + SLOT(3));
  const u16* ABb = (const u16*)(p.ws + SLOT(4));
  const float* DECb = (const float*)(p.ws + SLOT(1));
  u16* Yb = (u16*)(p.ws + SLOT(0));
  if (threadIdx.x >= 256) {
    const int tid = threadIdx.x - 256;
    const int ls = (tid & 127) >> 3, lc8 = tid & 7, pair = tid >> 7;
    const u16* pa = (pair ? KKb : Rb) + base + (size_t)ls * DM + lc8 * 8;
    const u16* pb = (pair ? ABb : Kb) + base + (size_t)ls * DM + lc8 * 8;
    const float* pd = DECb + base + (size_t)(tid >> 4) * DM + (tid & 15) * 4;
    const u16* pv = Vb + base + (size_t)((tid & 63) >> 2) * DM + rg * 16 + (tid & 3) * 4;
    auto gload = [&](ScanRegs& R, int t0) {
      const size_t o = (size_t)t0 * DM;
      R.a = *(const uint4*)(pa + o);
      R.b = *(const uint4*)(pb + o);
      R.d = *(const float4*)(pd + o);
      R.v = *(const uint2*)(pv + o);
    };
    auto lstore = [&](const ScanRegs& R, int buf) {
      float* L = (float*)(smem + buf * SC_BUF);
      float* la = L + (pair ? 2 : 0) * (SC_TC * 64) + ls * 64 + lc8 * 8;
      float* lb = L + (pair ? 3 : 1) * (SC_TC * 64) + ls * 64 + lc8 * 8;
      const float sg = pair ? -1.f : 1.f;
      *(float4*)(la) = make_float4(sg * bflo(R.a.x), sg * bfhi(R.a.x), sg * bflo(R.a.y), sg * bfhi(R.a.y));
      *(float4*)(la + 4) = make_float4(sg * bflo(R.a.z), sg * bfhi(R.a.z), sg * bflo(R.a.w), sg * bfhi(R.a.w));
      *(float4*)(lb) = make_float4(bflo(R.b.x), bfhi(R.b.x), bflo(R.b.y), bfhi(R.b.y));
      *(float4*)(lb + 4) = make_float4(bflo(R.b.z), bfhi(R.b.z), bflo(R.b.w), bfhi(R.b.w));
      *(float4*)(L + 4 * (SC_TC * 64) + (tid >> 4) * 64 + (tid & 15) * 4) = R.d;
      if (tid < 64) *(float4*)(L + 5 * (SC_TC * 64) + (tid >> 2) * 16 + (tid & 3) * 4) = make_float4(bflo(R.v.x), bfhi(R.v.x), bflo(R.v.y), bfhi(R.v.y));
    };
    ScanRegs X, Y;
    gload(X, 0);
    lstore(X, 0);
    gload(X, SC_TC);
    gload(Y, 2 * SC_TC);
    __syncthreads();
#pragma unroll 1
    for (int t0 = 0; t0 < TT; t0 += 2 * SC_TC) {
      lstore(X, 1);
      gload(X, min(t0 + 3 * SC_TC, TT - SC_TC));
      __syncthreads();
      lstore(Y, 0);
      gload(Y, min(t0 + 4 * SC_TC, TT - SC_TC));
      __syncthreads();
    }
  } else {
    const int tid = threadIdx.x, w = tid >> 6, lane = tid & 63;
    const int rl = lane >> 4, cl = lane & 15;
    const int row = rg * 16 + w * 4 + rl;
    u16* yp = Yb + base + row + (size_t)cl * DM;
    float S0 = 0.f, S1 = 0.f, S2 = 0.f, S3 = 0.f;
    struct StepIn { float4 r4, k4, n4, b4, d4; float v; };
    auto ldsload = [&](const float* L, int s) {
      StepIn q;
      q.n4 = *(const float4*)(L + 2 * (SC_TC * 64) + s * 64 + cl * 4);
      q.b4 = *(const float4*)(L + 3 * (SC_TC * 64) + s * 64 + cl * 4);
      q.d4 = *(const float4*)(L + 4 * (SC_TC * 64) + s * 64 + cl * 4);
      q.k4 = *(const float4*)(L + 1 * (SC_TC * 64) + s * 64 + cl * 4);
      q.v = L[5 * (SC_TC * 64) + s * 16 + w * 4 + rl];
      q.r4 = *(const float4*)(L + 0 * (SC_TC * 64) + s * 64 + cl * 4);
      return q;
    };
    float rp0 = 0.f, rp1 = 0.f, rp2 = 0.f, rp3 = 0.f;
    float yacc = 0.f;
    auto step = [&](const StepIn& c) -> float {
      float t0, t1, y0, y1, u0, u1, u2, u3;
      asm volatile(
          "v_mul_f32 %0, %8, %12\n\t"
          "v_mul_f32 %2, %8, %16\n\t"
          "v_mul_f32 %1, %10, %14\n\t"
          "v_mul_f32 %3, %10, %18\n\t"
          "v_fmac_f32 %0, %9, %13\n\t"
          "v_fmac_f32 %2, %9, %17\n\t"
          "v_fmac_f32 %1, %11, %15\n\t"
          "v_fmac_f32 %3, %11, %19\n\t"
          "v_add_f32 %0, %0, %1\n\t"
          "v_add_f32 %2, %2, %3\n\t"
          "v_mul_f32 %4, %20, %21\n\t"
          "v_add_f32_dpp %0, %0, %0 quad_perm:[1,0,3,2] row_mask:0xf bank_mask:0xf bound_ctrl:1\n\t"
          "v_add_f32_dpp %2, %2, %2 quad_perm:[1,0,3,2] row_mask:0xf bank_mask:0xf bound_ctrl:1\n\t"
          "v_mul_f32 %5, %20, %22\n\t"
          "v_add_f32_dpp %0, %0, %0 quad_perm:[2,3,0,1] row_mask:0xf bank_mask:0xf bound_ctrl:1\n\t"
          "v_add_f32_dpp %2, %2, %2 quad_perm:[2,3,0,1] row_mask:0xf bank_mask:0xf bound_ctrl:1\n\t"
          "v_mul_f32 %6, %20, %23\n\t"
          "v_add_f32_dpp %0, %0, %0 row_ror:4 row_mask:0xf bank_mask:0xf bound_ctrl:1\n\t"
          "v_add_f32_dpp %2, %2, %2 row_ror:4 row_mask:0xf bank_mask:0xf bound_ctrl:1\n\t"
          "v_mul_f32 %7, %20, %24\n\t"
          "v_add_f32_dpp %0, %0, %0 row_ror:8 row_mask:0xf bank_mask:0xf bound_ctrl:1\n\t"
          "v_add_f32_dpp %2, %2, %2 row_ror:8 row_mask:0xf bank_mask:0xf bound_ctrl:1\n\t"
          : "=&v"(t0), "=&v"(t1), "=&v"(y0), "=&v"(y1), "=&v"(u0), "=&v"(u1), "=&v"(u2), "=&v"(u3)
          : "v"(S0), "v"(S1), "v"(S2), "v"(S3), "v"(c.n4.x), "v"(c.n4.y), "v"(c.n4.z), "v"(c.n4.w),
            "v"(rp0), "v"(rp1), "v"(rp2), "v"(rp3), "v"(c.v), "v"(c.k4.x), "v"(c.k4.y), "v"(c.k4.z), "v"(c.k4.w));
      asm volatile(
          "v_fmac_f32 %4, %8, %9\n\t"
          "v_fmac_f32 %5, %8, %10\n\t"
          "v_fmac_f32 %6, %8, %11\n\t"
          "v_fmac_f32 %7, %8, %12\n\t"
          "v_fma_f32 %0, %0, %13, %4\n\t"
          "v_fma_f32 %1, %1, %14, %5\n\t"
          "v_fma_f32 %2, %2, %15, %6\n\t"
          "v_fma_f32 %3, %3, %16, %7\n\t"
          : "+v"(S0), "+v"(S1), "+v"(S2), "+v"(S3), "+v"(u0), "+v"(u1), "+v"(u2), "+v"(u3)
          : "v"(t0), "v"(c.b4.x), "v"(c.b4.y), "v"(c.b4.z), "v"(c.b4.w), "v"(c.d4.x), "v"(c.d4.y), "v"(c.d4.z), "v"(c.d4.w));
      rp0 = c.r4.x; rp1 = c.r4.y; rp2 = c.r4.z; rp3 = c.r4.w;
      return y0;
    };
    auto compute = [&](int buf, int t0) {
      const float* L = (const float*)(smem + buf * SC_BUF);
      StepIn cur = ldsload(L, 0);
#pragma unroll
      for (int s = 0; s < SC_TC; ++s) {
        StepIn nxt = cur;
        if (s + 1 < SC_TC) nxt = ldsload(L, s + 1);
        const float y = step(cur);
        if (s == 0) {
          yacc = (cl == 15) ? y : yacc;
          if (t0 > 0) yp[(size_t)(t0 - SC_TC) * DM] = f2bf(yacc);
        } else {
          yacc = (cl == s - 1) ? y : yacc;
        }
        cur = nxt;
        if ((s & 3) == 3) __builtin_amdgcn_sched_barrier(0);
      }
    };
    __syncthreads();
#pragma unroll 1
    for (int t0 = 0; t0 < TT; t0 += 2 * SC_TC) {
      compute(0, t0);
      __syncthreads();
      compute(1, t0 + SC_TC);
      __syncthreads();
    }
    {
      float y = (S0 * rp0 + S1 * rp1) + (S2 * rp2 + S3 * rp3);
      y = allreduce16(y);
      yacc = (cl == 15) ? y : yacc;
      yp[(size_t)(TT - SC_TC) * DM] = f2bf(yacc);
    }
  }
}

__device__ __forceinline__ void phase_gn(const Params& p) {
  const u16* R = (const u16*)(p.ws + SLOT(6));
  const u16* Kp = (const u16*)DSLOT(p, 0);
  const u16* V = (const u16*)DSLOT(p, 1);
  const u16* G = (const u16*)(p.ws + SLOT(5));
  u16* Y = (u16*)(p.ws + SLOT(0));
  const float* rk = p.in[17];
  const float* lg = p.in[18];
  const float* lb = p.in[19];
  const size_t nchunks = (size_t)MT * 128;
  const size_t stride = (size_t)gridDim.x * NT;
  for (size_t q = (size_t)blockIdx.x * NT + threadIdx.x; q < nchunks; q += stride) {
    const size_t off = q * 8;
    const int c = (int)(off & (DM - 1));
    float y[8], r[8], k[8], v[8], g[8];
    unpack8(*(const uint4*)(Y + off), y); unpack8(*(const uint4*)(R + off), r); unpack8(*(const uint4*)(Kp + off), k);
    unpack8(*(const uint4*)(V + off), v); unpack8(*(const uint4*)(G + off), g);
    float s = 0.f, rks = 0.f;
#pragma unroll
    for (int i = 0; i < 8; ++i) { s += y[i]; rks += r[i] * k[i] * rk[c + i]; }
    s += __shfl_xor(s, 1); s += __shfl_xor(s, 2); s += __shfl_xor(s, 4);
    rks += __shfl_xor(rks, 1); rks += __shfl_xor(rks, 2); rks += __shfl_xor(rks, 4);
    const float mean = s * (1.f / 64.f);
    float vs = 0.f;
#pragma unroll
    for (int i = 0; i < 8; ++i) { float d = y[i] - mean; vs += d * d; }
    vs += __shfl_xor(vs, 1); vs += __shfl_xor(vs, 2); vs += __shfl_xor(vs, 4);
    const float rstd = rsqrtf(vs * (1.f / 64.f) + 64e-5f);
    float z[8];
#pragma unroll
    for (int i = 0; i < 8; ++i) z[i] = ((y[i] - mean) * rstd * lg[c + i] + lb[c + i] + rks * v[i]) * g[i];
    *(uint4*)(Y + off) = pack8(z);
  }
}

__device__ __forceinline__ void phase_kmean(const Params& p) {
  const u16* Kb = (const u16*)(p.ws + SLOT(1));
  float* km = (float*)(p.ws + OFF_KMEAN);
  const int lane = threadIdx.x & 63;
  const int gw = blockIdx.x * NWV + (threadIdx.x >> 6), nw = gridDim.x * NWV;
  for (int it = gw; it < 2048; it += nw) {
    const int bh = it >> 5, n = it & 31, b = bh >> 4, h = bh & 15;
    const u16* kp = Kb + ((size_t)b * TT + n * 256 + (lane >> 3)) * DM + h * 64 + (lane & 7) * 8;
    float s[8] = {0.f, 0.f, 0.f, 0.f, 0.f, 0.f, 0.f, 0.f};
#pragma unroll 8
    for (int j = 0; j < 32; ++j) {
      float f[8]; unpack8(*(const uint4*)(kp + (size_t)j * 8 * DM), f);
#pragma unroll
      for (int q = 0; q < 8; ++q) s[q] += f[q];
    }
#pragma unroll
    for (int q = 0; q < 8; ++q) { s[q] += __shfl_xor(s[q], 8); s[q] += __shfl_xor(s[q], 16); s[q] += __shfl_xor(s[q], 32); }
    if (lane < 8) {
      float* o = km + (size_t)it * 64 + lane * 8;
      *(float4*)o = make_float4(s[0] * (1.f / 256.f), s[1] * (1.f / 256.f), s[2] * (1.f / 256.f), s[3] * (1.f / 256.f));
      *(float4*)(o + 4) = make_float4(s[4] * (1.f / 256.f), s[5] * (1.f / 256.f), s[6] * (1.f / 256.f), s[7] * (1.f / 256.f));
    }
  }
}

__device__ __forceinline__ void phase_gate(const Params& p) {
  const u16* Q = (const u16*)(p.ws + SLOT(4));
  const float* km = (const float*)(p.ws + OFF_KMEAN);
  int* cnt = (int*)(p.ws + OFF_CNT);
  u16* lists = (u16*)(p.ws + SLOT(5));
  float* lse = (float*)(p.ws + OFF_LSE);
  const int lane = threadIdx.x & 63;
  const int gw = blockIdx.x * NWV + (threadIdx.x >> 6), nw = gridDim.x * NWV;
  for (int it0 = gw; it0 < 8192; it0 += nw) {
    const int it = __builtin_amdgcn_readfirstlane(it0);
    const int bh = it >> 7, qg = it & 127, b = bh >> 4, h = bh & 15;
    const int blk = qg >> 2;
    const int t = qg * 64 + lane;
    const size_t m = (size_t)b * TT + t;
    float q[64];
    {
      const uint4* qp = (const uint4*)(Q + m * DM + h * 64);
#pragma unroll
      for (int i = 0; i < 8; ++i) unpack8(qp[i], q + 8 * i);
    }
    float s0 = -3e38f, s1 = -3e38f, s2 = -3e38f;
    int i0 = 0, i1 = 0, i2 = 0;
    for (int n = 0; n < blk; ++n) {
      const float* kr = km + ((size_t)bh * 32 + n) * 64;
      float s = 0.f;
#pragma unroll
      for (int d = 0; d < 64; ++d) s += q[d] * kr[d];
      if (s > s0) { s2 = s1; i2 = i1; s1 = s0; i1 = i0; s0 = s; i0 = n; }
      else if (s > s1) { s2 = s1; i2 = i1; s1 = s; i1 = n; }
      else if (s > s2) { s2 = s; i2 = n; }
    }
    const int nsel = min(3, blk);
    unsigned long long mymask = 0ull;
    for (int n = 0; n < blk; ++n) {
      const bool sel = (i0 == n) || (nsel > 1 && i1 == n) || (nsel > 2 && i2 == n);
      const unsigned long long mk = __ballot(sel);
      if (lane == n) mymask = mk;
    }
    const int tot = __popcll(mymask);
    int base = 0;
    if (lane < blk && tot > 0) base = atomicAdd(&cnt[bh * 32 + lane], tot);
    const unsigned mlo = (unsigned)mymask, mhi = (unsigned)(mymask >> 32);
    const unsigned long long below = (1ull << lane) - 1ull;
#pragma unroll
    for (int s = 0; s < 3; ++s) {
      const int n = (s == 0) ? i0 : (s == 1) ? i1 : i2;
      const unsigned lo = __shfl(mlo, n), hi = __shfl(mhi, n);
      const int bs = __shfl(base, n);
      if (s < nsel) {
        const unsigned long long mk = ((unsigned long long)hi << 32) | lo;
        const int pos = bs + __popcll(mk & below);
        lists[(size_t)(bh * 32 + n) * 8192 + pos] = (u16)(t | (s << 13));
      } else {
        lse[(size_t)s * MT * 16 + m * 16 + h] = -1e30f;
      }
    }
  }
}

constexpr int VT_LD = 528;
__device__ __forceinline__ int swz(int row, int chunk) { return row * 128 + ((chunk ^ ((row >> 1) & 7)) << 4); }

template <bool OWN>
__device__ __forceinline__ void attn_tile(const bf16x8 q0, const bf16x8 q1, int tloc, const unsigned char* smem,
                                          float& mout, float& lout, f32x4 O[4]) {
  const int lane = threadIdx.x & 63, g = lane >> 4, c16 = lane & 15;
  f32x4 S[16];
#pragma unroll
  for (int kt = 0; kt < 16; ++kt) {
    const int row = kt * 16 + c16;
    bf16x8 k0 = *(const bf16x8*)(smem + swz(row, g));
    bf16x8 k1 = *(const bf16x8*)(smem + swz(row, g + 4));
    f32x4 z = (f32x4){0.f, 0.f, 0.f, 0.f};
    z = __builtin_amdgcn_mfma_f32_16x16x32_bf16(k0, q0, z, 0, 0, 0);
    z = __builtin_amdgcn_mfma_f32_16x16x32_bf16(k1, q1, z, 0, 0, 0);
    S[kt] = z;
    if ((kt & 3) == 3) __builtin_amdgcn_sched_barrier(0);
  }
  float mx = -3e38f;
#pragma unroll
  for (int kt = 0; kt < 16; ++kt)
#pragma unroll
    for (int r = 0; r < 4; ++r) {
      float s = S[kt][r] * (0.125f * 1.44269504f);
      if (OWN) { if (kt * 16 + 4 * g + r > tloc) s = -3e38f; }
      S[kt][r] = s;
      mx = fmaxf(mx, s);
    }
  mx = fmaxf(mx, __shfl_xor(mx, 16));
  mx = fmaxf(mx, __shfl_xor(mx, 32));
  float l = 0.f;
#pragma unroll
  for (int kt = 0; kt < 16; ++kt)
#pragma unroll
    for (int r = 0; r < 4; ++r) {
      float pv = __builtin_amdgcn_exp2f(S[kt][r] - mx);
      S[kt][r] = pv;
      l += pv;
    }
  l += __shfl_xor(l, 16);
  l += __shfl_xor(l, 32);
#pragma unroll
  for (int dt = 0; dt < 4; ++dt) O[dt] = (f32x4){0.f, 0.f, 0.f, 0.f};
  const unsigned char* vb = smem + 32768;
#pragma unroll
  for (int j = 0; j < 8; ++j) {
    union { bf16x8 v; unsigned u[4]; } pf;
    pf.u[0] = pack2(S[2 * j][0], S[2 * j][1]);
    pf.u[1] = pack2(S[2 * j][2], S[2 * j][3]);
    pf.u[2] = pack2(S[2 * j + 1][0], S[2 * j + 1][1]);
    pf.u[3] = pack2(S[2 * j + 1][2], S[2 * j + 1][3]);
#pragma unroll
    for (int dt = 0; dt < 4; ++dt) {
      const unsigned char* vp = vb + (dt * 16 + c16) * VT_LD + (32 * j + 4 * g) * 2;
      union { bf16x8 v; uint2 h[2]; } vf;
      vf.h[0] = *(const uint2*)(vp);
      vf.h[1] = *(const uint2*)(vp + 32);
      O[dt] = __builtin_amdgcn_mfma_f32_16x16x32_bf16(vf.v, pf.v, O[dt], 0, 0, 0);
    }
    if (j & 1) __builtin_amdgcn_sched_barrier(0);
  }
  mout = mx * 0.69314718f; lout = l;
}

__device__ __forceinline__ u16* part_ptr(const Params& p, int slot) {
  return (u16*)(p.ws + (slot == 0 ? SLOT(0) : slot == 1 ? SLOT(3) : SLOT(6)));
}

struct AItem { int li, seg, b, h, n, c; };

template <bool OWN>
__device__ __forceinline__ void phase_attn(const Params& p, unsigned char* smem) {
  const int tid = threadIdx.x, lane = tid & 63, w = tid >> 6, g = lane >> 4, c16 = lane & 15;
  const int G = gridDim.x;
  const int* cnt = (const int*)(p.ws + OFF_CNT);
  const u16* lists = (const u16*)(p.ws + SLOT(5));
  u16* Q = (u16*)(p.ws + SLOT(4));
  float* lse = (float*)(p.ws + OFF_LSE);
  int* offs = (int*)(smem + 66560);
  unsigned char* Qs = smem + 75008;
  unsigned* entl = (unsigned*)(smem + 75008 + 16384);
  int total = 4096;
  if (!OWN) {
    int* part = (int*)smem;
    int loc[4]; int s = 0;
#pragma unroll
    for (int i = 0; i < 4; ++i) { loc[i] = (cnt[tid * 4 + i] + 127) >> 7; s += loc[i]; }
    part[tid] = s;
    __syncthreads();
    if (tid == 0) { int a = 0; for (int i = 0; i < NT; ++i) { int v = part[i]; part[i] = a; a += v; } offs[2048] = a; }
    __syncthreads();
    int a = part[tid];
#pragma unroll
    for (int i = 0; i < 4; ++i) { offs[tid * 4 + i] = a; a += loc[i]; }
    __syncthreads();
    total = offs[2048];
  }
  if ((int)blockIdx.x >= total) return;
  const int J = (total - 1 - (int)blockIdx.x) / G + 1;
  int* itab = (int*)(smem + 75008 + 16384 + 512);
  int* ctab = itab + 1024;
  if (!OWN) {
    for (int j = tid; j < J; j += NT) {
      const int it_ = blockIdx.x + j * G;
      int lo = 0, hi = 2048;
      while (hi - lo > 1) { int mid = (lo + hi) >> 1; if (offs[mid] <= it_) lo = mid; else hi = mid; }
      itab[j] = lo | ((it_ - offs[lo]) << 11);
      ctab[j] = cnt[lo];
    }
    __syncthreads();
  }

  auto decode = [&](int j) {
    AItem d;
    if (OWN) { const int it = blockIdx.x + j * G; d.li = it >> 1; d.seg = it & 1; d.c = 0; }
    else {
      const int pk = itab[j];
      d.li = pk & 2047; d.seg = pk >> 11; d.c = ctab[j];
    }
    const int bh = d.li >> 5;
    d.n = d.li & 31; d.b = bh >> 4; d.h = bh & 15;
    return d;
  };
  auto load_ent1 = [&](const AItem& d, const int i) -> unsigned {
    const int row = (tid >> 3) + 64 * i;
    if (OWN) return (unsigned)(d.n * 256 + d.seg * 128 + row) | 0x8000u;
    const int qi = d.seg * 128 + row;
    const int qc = min(qi, 8191);
    unsigned v = lists[(size_t)d.li * 8192 + qc];
    return (qi < d.c) ? (v | 0x8000u) : 0u;
  };
  uint4 kr0, kr1, kr2, kr3, vr0, vr1, vr2, vr3, qr0, qr1;
  auto load_kvq = [&](const AItem& d, const unsigned e0, const unsigned e1) {
    const u16* Kb = (const u16*)(p.ws + SLOT(1)) + ((size_t)d.b * TT + d.n * 256) * DM + d.h * 64;
    const u16* Vt = (const u16*)(p.ws + SLOT(2)) + (size_t)(((d.b * 16 + d.h) * 32 + d.n) * 64) * 256;
#define LDKV(i, K_, V_) { const int idx = tid + NT * (i); K_ = *(const uint4*)(Kb + (size_t)(idx >> 3) * DM + (idx & 7) * 8); V_ = *(const uint4*)(Vt + (size_t)idx * 8); }
    LDKV(0, kr0, vr0) LDKV(1, kr1, vr1) LDKV(2, kr2, vr2) LDKV(3, kr3, vr3)
#undef LDKV
    qr0 = *(const uint4*)(Q + ((size_t)d.b * TT + (e0 & 8191u)) * DM + d.h * 64 + (tid & 7) * 8);
    qr1 = *(const uint4*)(Q + ((size_t)d.b * TT + (e1 & 8191u)) * DM + d.h * 64 + (tid & 7) * 8);
  };
  auto store_lds = [&](const unsigned e0, const unsigned e1) {
#define STKV(i, K_, V_) { const int idx = tid + NT * (i); *(uint4*)(smem + swz(idx >> 3, idx & 7)) = K_; *(uint4*)(smem + 32768 + (idx >> 5) * VT_LD + (idx & 31) * 16) = V_; }
    STKV(0, kr0, vr0) STKV(1, kr1, vr1) STKV(2, kr2, vr2) STKV(3, kr3, vr3)
#undef STKV
    *(uint4*)(Qs + swz(tid >> 3, tid & 7)) = qr0;
    *(uint4*)(Qs + swz((tid >> 3) + 64, tid & 7)) = qr1;
    if ((tid & 7) == 0) { entl[tid >> 3] = e0; entl[(tid >> 3) + 64] = e1; }
  };

  int it = 0;
  AItem dc = decode(0);
  unsigned ec0 = load_ent1(dc, 0), ec1 = load_ent1(dc, 1);
  load_kvq(dc, ec0, ec1);
  int itn = min(1, J - 1);
  AItem dn = decode(itn);
  unsigned en0 = load_ent1(dn, 0), en1 = load_ent1(dn, 1);
  while (true) {
    __syncthreads();
    store_lds(ec0, ec1);
    __syncthreads();
    load_kvq(dn, en0, en1);
    ec0 = en0; ec1 = en1;
    const AItem d = dc;
    dc = dn;
    itn = min(itn + 1, J - 1);
    dn = decode(itn);
    en0 = load_ent1(dn, 0); en1 = load_ent1(dn, 1);
    {
      const int row = w * 16 + c16;
      const unsigned ent = entl[row];
      const bool valid = (ent >> 15) != 0;
      const int t = ent & 8191, slot = (ent >> 13) & 3;
      const size_t m = (size_t)d.b * TT + t;
      const bf16x8 q0 = *(const bf16x8*)(Qs + swz(row, g));
      const bf16x8 q1 = *(const bf16x8*)(Qs + swz(row, g + 4));
      float mx, l; f32x4 O[4];
      attn_tile<OWN>(q0, q1, d.seg * 128 + row, smem, mx, l, O);
      if (!OWN) {
        if (valid) {
          const float inv = frcp_(l);
          u16* po = part_ptr(p, slot) + m * DM + d.h * 64;
#pragma unroll
          for (int dt = 0; dt < 4; ++dt) {
            uint2 o;
            o.x = pack2(O[dt][0] * inv, O[dt][1] * inv);
            o.y = pack2(O[dt][2] * inv, O[dt][3] * inv);
            *(uint2*)(po + dt * 16 + 4 * g) = o;
          }
          if (g == 0) lse[(size_t)slot * MT * 16 + m * 16 + d.h] = mx + __logf(l);
        }
      } else {
        float ls[3], M2 = mx;
#pragma unroll
        for (int s = 0; s < 3; ++s) { ls[s] = lse[(size_t)s * MT * 16 + m * 16 + d.h]; M2 = fmaxf(M2, ls[s]); }
        const float wo = __expf(mx - M2);
        float ws[3], den = l * wo;
#pragma unroll
        for (int s = 0; s < 3; ++s) { ws[s] = (ls[s] > -1e29f) ? __expf(ls[s] - M2) : 0.f; den += ws[s]; }
        const float inv = frcp_(den);
#pragma unroll
        for (int dt = 0; dt < 4; ++dt) {
          float o0 = O[dt][0] * wo, o1 = O[dt][1] * wo, o2 = O[dt][2] * wo, o3 = O[dt][3] * wo;
#pragma unroll
          for (int s = 0; s < 3; ++s) {
            if (ws[s] != 0.f) {
              const u16* pp = part_ptr(p, s) + m * DM + d.h * 64 + dt * 16 + 4 * g;
              uint2 u = *(const uint2*)pp;
              o0 += ws[s] * bflo(u.x); o1 += ws[s] * bfhi(u.x); o2 += ws[s] * bflo(u.y); o3 += ws[s] * bfhi(u.y);
            }
          }
          uint2 o;
          o.x = pack2(o0 * inv, o1 * inv);
          o.y = pack2(o2 * inv, o3 * inv);
          *(uint2*)(Q + m * DM + d.h * 64 + dt * 16 + 4 * g) = o;
        }
      }
    }
    it += 1;
    if (it >= J) break;
  }
}

#define TILE_LOOP(total) for (int _i = blockIdx.x, _G = gridDim.x, _tot = (total), _end = ((_tot + _G - 1) / _G) * _G; _i < _end; _i += _G)

#define EB(x) (1 << (x))
__device__ __forceinline__ void phase_rkv(const Params& p, unsigned char* smem) {
  const u16* wt = (const u16*)p.ws;
  TILE_LOOP(1536) {
    const int tile = tile_remap(_i);
    if (tile >= 1536) continue;
    const int s = tile >> 9, rem = tile & 511, mt = rem >> 2, nt = rem & 3;
    Epi e{};
    e.o16 = (s == 0) ? (u16*)(p.ws + SLOT(6)) : (u16*)DSLOT(p, s - 1); e.ldo = DM;
    gemm_tile<EB(EPI_BF16)>((const u16*)(p.ws + SLOT(s)), wt + WT_RKV + (size_t)s * M1, DM, mt * 256, nt * 256, EPI_BF16, e, smem);
  }
}

__device__ __forceinline__ void phase_lora1(const Params& p, unsigned char* smem) {
  const u16* wt = (const u16*)p.ws;
  u16* lora = (u16*)(p.ws + SLOT(0));
  TILE_LOOP(384) {
    const int tile = _i;
    if (tile >= 384) continue;
    const int j = tile >> 7, mt = tile & 127;
    Epi e{};
    e.o16 = lora + (size_t)j * MT * 256; e.ldo = 256;
    const u16* A = (const u16*)(p.ws + SLOT(3 + j));
    const u16* B = wt + WT_W1 + (size_t)j * 256 * 1024;
    const int epi = (j == 0) ? EPI_TANH : (j == 1) ? EPI_BF16 : EPI_SIG;
    gemm_tile<EB(EPI_TANH) | EB(EPI_BF16) | EB(EPI_SIG)>(A, B, DM, mt * 256, 0, epi, e, smem);
  }
}

__device__ __forceinline__ void phase_lora2(const Params& p, unsigned char* smem) {
  const u16* wt = (const u16*)p.ws;
  const u16* lora = (const u16*)(p.ws + SLOT(0));
  TILE_LOOP(1536) {
    const int tile = tile_remap(_i);
    if (tile >= 1536) continue;
    const int which = tile >> 9, rem = tile & 511, mt = rem >> 2, nt = rem & 3;
    Epi e{};
    e.o32 = (float*)(p.ws + SLOT(1));
    e.v0 = (which == 0) ? p.in[7] : p.in[10]; e.v1 = p.in[15]; e.v2 = p.in[16];
    e.kbuf = (u16*)DSLOT(p, 0); e.kkbuf = (u16*)(p.ws + SLOT(3)); e.abbuf = (u16*)(p.ws + SLOT(4));
    e.o16 = (u16*)(p.ws + SLOT(5)); e.ldo = DM;
    const int epi = (which == 0) ? EPI_DECAY : (which == 1) ? EPI_AK : EPI_BF16;
    gemm_tile<EB(EPI_DECAY) | EB(EPI_AK) | EB(EPI_BF16)>(lora + (size_t)which * MT * 256, wt + WT_W2 + (size_t)which * 256 * 1024, 256,
                                                        mt * 256, nt * 256, epi, e, smem);
  }
}

__device__ __forceinline__ void phase_resid(const Params& p, const u16* A, int K, const u16* Bt, const float* res32, const u16* res16,
                                            float* out32, u16* out16, int gate_off, unsigned char* smem) {
  const float* mod = (const float*)(p.ws + OFF_MOD);
  TILE_LOOP(512) {
    const int tile = tile_remap(_i);
    if (tile >= 512) continue;
    const int mt = tile >> 2, nt = tile & 3;
    Epi e{};
    e.o32 = out32; e.o16 = out16; e.res = res32; e.kbuf = (u16*)res16; e.gate = mod + gate_off;
    gemm_tile<EB(EPI_RESID)>(A, Bt, K, mt * 256, nt * 256, EPI_RESID, e, smem);
  }
}

__device__ __forceinline__ void phase_ffn_up(const Params& p, const u16* A, const u16* Bt, u16* act, unsigned char* smem) {
  TILE_LOOP(128 * 22) {
    const int tile = tile_remap(_i);
    if (tile >= 128 * 22) continue;
    const int st = tile >> 5, w = tile & 31;
    int mt2, nt2;
    if (st < 80) { mt2 = (st / 5) * 8 + (w >> 2); nt2 = (st % 5) * 4 + (w & 3); }
    else { mt2 = (st - 80) * 16 + (w >> 1); nt2 = 20 + (w & 1); }
    Epi e{};
    e.o16 = act;
    gemm_tile<EB(EPI_SWIGLU)>(A, Bt, DM, mt2 * 256, nt2 * 256, EPI_SWIGLU, e, smem);
  }
}

__device__ __forceinline__ void phase_qkv(const Params& p, unsigned char* smem) {
  const u16* wt = (const u16*)p.ws;
  TILE_LOOP(1536) {
    const int tile = tile_remap(_i);
    if (tile >= 1536) continue;
    const int which = tile >> 9, rem = tile & 511, mt = rem >> 2, nt = rem & 3;
    Epi e{};
    e.o16 = (u16*)(p.ws + (which == 0 ? SLOT(1) : which == 1 ? SLOT(2) : SLOT(4)));
    e.v0 = (which == 0) ? p.in[29] : p.in[31];
    const u16* A = (const u16*)(p.ws + (which == 2 ? SLOT(3) : SLOT(0)));
    const u16* B = wt + WT_KVK + (size_t)which * M1;
    const int epi = (which == 1) ? EPI_VT : EPI_HEADNORM;
    gemm_tile<EB(EPI_HEADNORM) | EB(EPI_VT)>(A, B, DM, mt * 256, nt * 256, epi, e, smem);
  }
}

constexpr int NPHASES = 21;
#ifdef ONLY_PHASE
#define PEN(k) ((k) == ONLY_PHASE)
#else
#define PEN(k) true
#endif
#define RUN(k, call) if (ph0 <= (k) && (k) < ph1) { if (PEN(k)) { call; } if ((k) + 1 < ph1) grid.sync(); }

__global__ void __launch_bounds__(512, 2) mega(Params p, int ph0, int ph1) {
  __shared__ __attribute__((aligned(16))) unsigned char smem[SMEM_BYTES];
  cg::grid_group grid = cg::this_grid();
  const float* mod = (const float*)(p.ws + OFF_MOD);
  const u16* wt = (const u16*)p.ws;
  RUN(0, phase_prep(p, smem))
  RUN(1, phase_norm_xs(p))
  RUN(2, phase_rkv(p, smem))
  RUN(3, phase_lora1(p, smem))
  RUN(4, phase_lora2(p, smem))
  RUN(5, phase_scan(p, smem))
  RUN(6, phase_gn(p))
  RUN(7, phase_resid(p, (const u16*)(p.ws + SLOT(0)), DM, wt + WT_WO, p.in[0], nullptr, nullptr, (u16*)(p.ws + SLOT(1)), 2048, smem))
  RUN(8, phase_norm((const u16*)(p.ws + SLOT(1)), p.in[2] + 1024, mod, 3072, 3072 + 1024, (u16*)(p.ws + SLOT(3)), nullptr, 0, 0, nullptr))
  RUN(9, phase_ffn_up(p, (const u16*)(p.ws + SLOT(3)), wt + WT_GU, (u16*)(p.ws + SLOT(4)), smem))
  RUN(10, phase_resid(p, (const u16*)(p.ws + SLOT(4)), FF, wt + WT_DN, nullptr, (const u16*)(p.ws + SLOT(1)), nullptr, (u16*)DSLOT(p, 0), 3072 + 2048, smem))
  RUN(11, phase_norm((const u16*)DSLOT(p, 0), p.in[24], mod, 12288, 12288 + 1024, (u16*)(p.ws + SLOT(0)), p.in[2] + 2048, 6144, 6144 + 1024, (u16*)(p.ws + SLOT(3))))
  RUN(12, phase_qkv(p, smem))
  RUN(13, phase_kmean(p))
  RUN(14, phase_gate(p))
  RUN(15, phase_attn<false>(p, smem))
  RUN(16, phase_attn<true>(p, smem))
  RUN(17, phase_resid(p, (const u16*)(p.ws + SLOT(4)), DM, wt + WT_MBO, nullptr, (const u16*)DSLOT(p, 0), nullptr, (u16*)(p.ws + SLOT(5)), 6144 + 2048, smem))
  RUN(18, phase_norm((const u16*)(p.ws + SLOT(5)), p.in[2] + 3072, mod, 9216, 9216 + 1024, (u16*)(p.ws + SLOT(0)), nullptr, 0, 0, nullptr))
  RUN(19, phase_ffn_up(p, (const u16*)(p.ws + SLOT(0)), wt + WT_GU + (size_t)5632 * 1024, (u16*)(p.ws + SLOT(1)), smem))
  RUN(20, phase_resid(p, (const u16*)(p.ws + SLOT(1)), FF, wt + WT_DN + (size_t)1024 * 2816, nullptr, (const u16*)(p.ws + SLOT(5)), p.out, nullptr, 9216 + 2048, smem))
}

extern "C" void kernel_launch(void* const* d_in, const int* in_sizes, int n_in, void* d_out, int out_size,
                              void* d_ws, size_t ws_size, hipStream_t stream) {
  static int grid_blocks = 0;
  if (!grid_blocks) {
    int dev = 0, cus = 0, per_cu = 0;
    (void)hipGetDevice(&dev);
    (void)hipDeviceGetAttribute(&cus, hipDeviceAttributeMultiprocessorCount, dev);
    (void)hipOccupancyMaxActiveBlocksPerMultiprocessor(&per_cu, mega, NT, 0);
    if (per_cu < 1) per_cu = 1;
    grid_blocks = cus;
    if (grid_blocks > cus * per_cu) grid_blocks = cus * per_cu;
    grid_blocks &= ~7;
  }
  Params p{};
  for (int i = 0; i < 33; ++i) p.in[i] = (const float*)d_in[i];
  p.out = (float*)d_out;
  p.ws = (unsigned char*)d_ws;
#if SINGLE_LAUNCH
  int ph0 = 0, ph1 = NPHASES;
  void* args[] = {&p, &ph0, &ph1};
  hipError_t e = hipLaunchCooperativeKernel((void*)mega, dim3(grid_blocks), dim3(NT), args, 0, stream);
  if (e != hipSuccess) fprintf(stderr, "cooperative launch failed: %s (grid %d)\n", hipGetErrorString(e), grid_blocks);
#else
  for (int ph = 0; ph < NPHASES; ++ph) mega<<<grid_blocks, NT, 0, stream>>>(p, ph, ph + 1);
#endif
}
```

```cpp
#include <hip/hip_runtime.h>
#include <hip/hip_cooperative_groups.h>
#include <cstdio>
namespace cg = cooperative_groups;

typedef unsigned short u16;
typedef __attribute__((ext_vector_type(8))) short bf16x8;
typedef __attribute__((ext_vector_type(4))) float f32x4;

#ifndef SINGLE_LAUNCH
#define SINGLE_LAUNCH 1
#endif

constexpr int NT = 512;
constexpr int NWV = 8;
constexpr int DM = 1024, NB = 4, TT = 8192, MT = NB * TT, FF = 2816, NH = 16;
constexpr int MODLD = 14336;
constexpr size_t MiB = 1u << 20;
constexpr size_t M1 = 1048576;

constexpr size_t WT_RKV = 0;
constexpr size_t WT_W1 = WT_RKV + 3 * M1;
constexpr size_t WT_A1 = WT_W1 + 256 * 1024;
constexpr size_t WT_G1 = WT_A1 + 256 * 1024;
constexpr size_t WT_W2 = WT_G1 + 256 * 1024;
constexpr size_t WT_A2 = WT_W2 + 256 * 1024;
constexpr size_t WT_G2 = WT_A2 + 256 * 1024;
constexpr size_t WT_WO = WT_G2 + 256 * 1024;
constexpr size_t WT_GU = WT_WO + M1;
constexpr size_t WT_DN = WT_GU + 2 * 5632 * 1024;
constexpr size_t WT_KVK = WT_DN + 2 * 1024 * 2816;
constexpr size_t WT_KVV = WT_KVK + M1;
constexpr size_t WT_Q = WT_KVV + M1;
constexpr size_t WT_MBO = WT_Q + M1;
constexpr size_t WT_END = WT_MBO + M1;
static_assert(WT_END * 2 <= 52 * MiB, "wt region");
constexpr size_t OFF_MOD = 52 * MiB;
constexpr size_t OFF_CNT = OFF_MOD + 4 * MODLD * 4;
constexpr size_t OFF_KMEAN = OFF_CNT + 2048 * 4;
constexpr size_t OFF_LSE = 53 * MiB;
constexpr size_t OFF_SLOT0 = 64 * MiB;
#define SLOT(i) (OFF_SLOT0 + (size_t)(i) * 64 * MiB)
#define DSLOT(p, i) ((unsigned char*)(p).out + (size_t)(i) * 64 * MiB)

constexpr int STG_LD = 132;
constexpr int STG_BYTES = 128 * STG_LD * 4;
constexpr int SMEM_BYTES = 2 * STG_BYTES + 256;

struct Params {
  const float* in[33];
  float* out;
  unsigned char* ws;
};

typedef __bf16 bf2v __attribute__((ext_vector_type(2)));
typedef float f2v __attribute__((ext_vector_type(2)));
__device__ __forceinline__ unsigned pack2(float a, float b) {
  f2v f = {a, b};
  bf2v r = __builtin_convertvector(f, bf2v);
  return __builtin_bit_cast(unsigned, r);
}
__device__ __forceinline__ u16 f2bf(float f) { return (u16)(pack2(f, 0.f) & 0xffffu); }
__device__ __forceinline__ float bf2f(u16 h) { return __uint_as_float(((unsigned)h) << 16); }
__device__ __forceinline__ float bflo(unsigned x) { return __uint_as_float(x << 16); }
__device__ __forceinline__ float bfhi(unsigned x) { return __uint_as_float(x & 0xffff0000u); }
__device__ __forceinline__ float frcp_(float x) { return __builtin_amdgcn_rcpf(x); }
__device__ __forceinline__ float sigmoidf_(float x) { return frcp_(1.f + __expf(-x)); }
__device__ __forceinline__ float siluf_(float x) { return x * frcp_(1.f + __expf(-x)); }
__device__ __forceinline__ float tanhf_(float x) { return 1.f - 2.f * frcp_(1.f + __expf(2.f * x)); }

template <int CTRL>
__device__ __forceinline__ float dppf(float x) {
  return __int_as_float(__builtin_amdgcn_update_dpp(0, __float_as_int(x), CTRL, 0xF, 0xF, true));
}
__device__ __forceinline__ float allreduce16(float x) {
  x += dppf<0xB1>(x);
  x += dppf<0x4E>(x);
  x += dppf<0x124>(x);
  x += dppf<0x128>(x);
  return x;
}
__device__ __forceinline__ float wave_sum(float x) {
#pragma unroll
  for (int o = 32; o >= 1; o >>= 1) x += __shfl_xor(x, o);
  return x;
}

__device__ __forceinline__ void unpack8(uint4 u, float* f) {
  f[0] = bflo(u.x); f[1] = bfhi(u.x); f[2] = bflo(u.y); f[3] = bfhi(u.y);
  f[4] = bflo(u.z); f[5] = bfhi(u.z); f[6] = bflo(u.w); f[7] = bfhi(u.w);
}
__device__ __forceinline__ uint4 pack8(const float* f) {
  uint4 o; o.x = pack2(f[0], f[1]); o.y = pack2(f[2], f[3]); o.z = pack2(f[4], f[5]); o.w = pack2(f[6], f[7]); return o;
}

struct TJob { const float* src; u16* dst; int K, N, Kp, Np, mode, which; };

__device__ __forceinline__ TJob get_job(const Params& p, int j) {
  u16* wt = (u16*)p.ws;
  TJob t;
  t.mode = 0; t.which = 0;
  switch (j) {
    case 0: t.src = p.in[6]; t.dst = wt + WT_RKV; t.K = 1024; t.N = 1024; t.Kp = 1024; t.Np = 1024; break;
    case 1: t.src = p.in[6] + M1; t.dst = wt + WT_RKV + M1; t.K = 1024; t.N = 1024; t.Kp = 1024; t.Np = 1024; break;
    case 2: t.src = p.in[6] + 2 * M1; t.dst = wt + WT_RKV + 2 * M1; t.K = 1024; t.N = 1024; t.Kp = 1024; t.Np = 1024; break;
    case 3: t.src = p.in[8]; t.dst = wt + WT_W1; t.K = 1024; t.N = 64; t.Kp = 1024; t.Np = 256; break;
    case 4: t.src = p.in[11]; t.dst = wt + WT_A1; t.K = 1024; t.N = 64; t.Kp = 1024; t.Np = 256; break;
    case 5: t.src = p.in[13]; t.dst = wt + WT_G1; t.K = 1024; t.N = 160; t.Kp = 1024; t.Np = 256; break;
    case 6: t.src = p.in[9]; t.dst = wt + WT_W2; t.K = 64; t.N = 1024; t.Kp = 256; t.Np = 1024; break;
    case 7: t.src = p.in[12]; t.dst = wt + WT_A2; t.K = 64; t.N = 1024; t.Kp = 256; t.Np = 1024; break;
    case 8: t.src = p.in[14]; t.dst = wt + WT_G2; t.K = 160; t.N = 1024; t.Kp = 256; t.Np = 1024; break;
    case 9: t.src = p.in[20]; t.dst = wt + WT_WO; t.K = 1024; t.N = 1024; t.Kp = 1024; t.Np = 1024; break;
    case 10: t.src = p.in[21]; t.dst = wt + WT_GU; t.K = 1024; t.N = 2816; t.Kp = 1024; t.Np = 2816; t.mode = 1; t.which = 0; break;
    case 11: t.src = p.in[22]; t.dst = wt + WT_GU; t.K = 1024; t.N = 2816; t.Kp = 1024; t.Np = 2816; t.mode = 1; t.which = 1; break;
    case 12: t.src = p.in[21] + (size_t)1024 * 2816; t.dst = wt + WT_GU + (size_t)5632 * 1024; t.K = 1024; t.N = 2816; t.Kp = 1024; t.Np = 2816; t.mode = 1; t.which = 0; break;
    case 13: t.src = p.in[22] + (size_t)1024 * 2816; t.dst = wt + WT_GU + (size_t)5632 * 1024; t.K = 1024; t.N = 2816; t.Kp = 1024; t.Np = 2816; t.mode = 1; t.which = 1; break;
    case 14: t.src = p.in[23]; t.dst = wt + WT_DN; t.K = 2816; t.N = 1024; t.Kp = 2816; t.Np = 1024; break;
    case 15: t.src = p.in[23] + (size_t)1024 * 2816; t.dst = wt + WT_DN + (size_t)1024 * 2816; t.K = 2816; t.N = 1024; t.Kp = 2816; t.Np = 1024; break;
    case 16: t.src = p.in[27]; t.dst = wt + WT_KVK; t.K = 1024; t.N = 1024; t.Kp = 1024; t.Np = 1024; break;
    case 17: t.src = p.in[28]; t.dst = wt + WT_KVV; t.K = 1024; t.N = 1024; t.Kp = 1024; t.Np = 1024; break;
    case 18: t.src = p.in[30]; t.dst = wt + WT_Q; t.K = 1024; t.N = 1024; t.Kp = 1024; t.Np = 1024; break;
    default: t.src = p.in[32]; t.dst = wt + WT_MBO; t.K = 1024; t.N = 1024; t.Kp = 1024; t.Np = 1024; break;
  }
  return t;
}
constexpr int NJOBS = 20;

__device__ __forceinline__ void phase_prep(const Params& p, unsigned char* smem) {
  const int tid = threadIdx.x;
  if (blockIdx.x == 0) {
    int* cnt = (int*)(p.ws + OFF_CNT);
    for (int i = tid; i < 2048; i += NT) cnt[i] = 0;
  }
  int total = 0;
  for (int j = 0; j < NJOBS; ++j) { TJob t = get_job(p, j); total += (t.Np >> 6) * (t.Kp >> 6); }
  float (*tile)[65] = (float (*)[65])smem;
  const int NADA = MODLD / 64;
  auto decode_tile = [&](int it_, TJob& t, int& n0, int& k0) {
    int j = 0, lt = it_;
    t = get_job(p, 0);
    while (true) {
      int n = (t.Np >> 6) * (t.Kp >> 6);
      if (lt < n) break;
      lt -= n; ++j; t = get_job(p, j);
    }
    const int nkt = t.Kp >> 6;
    n0 = (lt / nkt) * 64; k0 = (lt % nkt) * 64;
  };
  auto tile_load = [&](const TJob& t, int n0, int k0, float4& v0, float4& v1) {
    {
      const int kk = tid >> 4, n4 = (tid & 15) * 4;
      const int k = k0 + kk, n = n0 + n4;
      v0 = make_float4(0.f, 0.f, 0.f, 0.f);
      if (k < t.K && n < t.N) v0 = *(const float4*)(t.src + (size_t)k * t.N + n);
    }
    {
      const int kk = (tid + NT) >> 4, n4 = (tid & 15) * 4;
      const int k = k0 + kk, n = n0 + n4;
      v1 = make_float4(0.f, 0.f, 0.f, 0.f);
      if (k < t.K && n < t.N) v1 = *(const float4*)(t.src + (size_t)k * t.N + n);
    }
  };
  int it = blockIdx.x;
  {
    TJob t; int n0 = 0, k0 = 0; float4 v0, v1;
    if (it < total) { decode_tile(it, t, n0, k0); tile_load(t, n0, k0, v0, v1); }
    while (it < total) {
      {
        const int kk = tid >> 4, n4 = (tid & 15) * 4;
        tile[kk][n4] = v0.x; tile[kk][n4 + 1] = v0.y; tile[kk][n4 + 2] = v0.z; tile[kk][n4 + 3] = v0.w;
        tile[kk + 32][n4] = v1.x; tile[kk + 32][n4 + 1] = v1.y; tile[kk + 32][n4 + 2] = v1.z; tile[kk + 32][n4 + 3] = v1.w;
      }
      __syncthreads();
      const int itn = it + gridDim.x;
      TJob tn = t; int n0n = n0, k0n = k0;
      if (itn < total) { decode_tile(itn, tn, n0n, k0n); tile_load(tn, n0n, k0n, v0, v1); }
      {
        const int nn = tid >> 3, kk0 = (tid & 7) * 8;
        const int n = n0 + nn;
        const int drow = t.mode ? ((n >> 4) * 32 + t.which * 16 + (n & 15)) : n;
        float f[8];
#pragma unroll
        for (int q = 0; q < 8; ++q) f[q] = tile[kk0 + q][nn];
        *(uint4*)(t.dst + (size_t)drow * t.Kp + k0 + kk0) = pack8(f);
      }
      __syncthreads();
      t = tn; n0 = n0n; k0 = k0n; it = itn;
    }
  }
  for (; it < total + NADA; it += gridDim.x) {
    {
      const int a = it - total;
      const int ncol0 = a * 64;
      const float* W; const float* bias; int ldw, nl0;
      if (ncol0 < 12288) {
        int g = ncol0 / 3072;
        W = p.in[3] + (size_t)g * 1024 * 3072; bias = p.in[4] + g * 3072; ldw = 3072; nl0 = ncol0 - g * 3072;
      } else {
        W = p.in[25]; bias = p.in[26]; ldw = 2048; nl0 = ncol0 - 12288;
      }
      float* sc = (float*)smem;
      float* red = (float*)(smem + 16384);
      const float* c = p.in[1];
      for (int i = tid; i < 4096; i += NT) sc[i] = siluf_(c[i]);
      __syncthreads();
      const int w = tid >> 6, lane = tid & 63;
      float a0 = 0, a1 = 0, a2 = 0, a3 = 0;
      const float* wp = W + (size_t)(w * 128) * ldw + nl0 + lane;
#pragma unroll 8
      for (int k = 0; k < 128; ++k) {
        float wv = wp[(size_t)k * ldw];
        int kk = w * 128 + k;
        a0 += sc[kk] * wv; a1 += sc[1024 + kk] * wv; a2 += sc[2048 + kk] * wv; a3 += sc[3072 + kk] * wv;
      }
      red[(w * 4 + 0) * 64 + lane] = a0; red[(w * 4 + 1) * 64 + lane] = a1;
      red[(w * 4 + 2) * 64 + lane] = a2; red[(w * 4 + 3) * 64 + lane] = a3;
      __syncthreads();
      if (tid < 256) {
        int b = tid >> 6;
        float s = 0.f;
#pragma unroll
        for (int ww = 0; ww < 8; ++ww) s += red[(ww * 4 + b) * 64 + lane];
        float* mod = (float*)(p.ws + OFF_MOD);
        mod[b * MODLD + ncol0 + lane] = s + bias[nl0 + lane];
      }
      __syncthreads();
    }
  }
}

__device__ __forceinline__ void phase_norm(const u16* __restrict__ x, const float* __restrict__ g1, const float* __restrict__ mod,
                           int sh1, int sc1, u16* __restrict__ o1,
                           const float* __restrict__ g2, int sh2, int sc2, u16* __restrict__ o2) {
  const int lane = threadIdx.x & 63;
  const int gw = blockIdx.x * NWV + (threadIdx.x >> 6);
  const int nw = gridDim.x * NWV;
  for (int row = gw; row < MT; row += nw) {
    const uint2* xp = (const uint2*)(x + (size_t)row * DM);
    float4 v[4];
    float ss = 0.f;
#pragma unroll
    for (int i = 0; i < 4; ++i) {
      const uint2 t = xp[lane + 64 * i];
      v[i] = make_float4(bflo(t.x), bfhi(t.x), bflo(t.y), bfhi(t.y));
      ss += v[i].x * v[i].x + v[i].y * v[i].y + v[i].z * v[i].z + v[i].w * v[i].w;
    }
    ss = wave_sum(ss);
    const float rs = rsqrtf(ss * (1.f / DM) + 1e-6f);
    const int b = row >> 13;
    const float* mb = mod + (size_t)b * MODLD;
#pragma unroll
    for (int i = 0; i < 4; ++i) {
      const int c = (lane + 64 * i) * 4;
      float4 gg = *(const float4*)(g1 + c);
      float4 sh = *(const float4*)(mb + sh1 + c);
      float4 sc = *(const float4*)(mb + sc1 + c);
      uint2 o;
      o.x = pack2(v[i].x * rs * gg.x * (1.f + sc.x) + sh.x, v[i].y * rs * gg.y * (1.f + sc.y) + sh.y);
      o.y = pack2(v[i].z * rs * gg.z * (1.f + sc.z) + sh.z, v[i].w * rs * gg.w * (1.f + sc.w) + sh.w);
      *(uint2*)(o1 + (size_t)row * DM + c) = o;
      if (o2) {
        float4 gg2 = *(const float4*)(g2 + c);
        float4 sh_ = *(const float4*)(mb + sh2 + c);
        float4 sc_ = *(const float4*)(mb + sc2 + c);
        uint2 q;
        q.x = pack2(v[i].x * rs * gg2.x * (1.f + sc_.x) + sh_.x, v[i].y * rs * gg2.y * (1.f + sc_.y) + sh_.y);
        q.y = pack2(v[i].z * rs * gg2.z * (1.f + sc_.z) + sh_.z, v[i].w * rs * gg2.w * (1.f + sc_.w) + sh_.w);
        *(uint2*)(o2 + (size_t)row * DM + c) = q;
      }
    }
  }
}

__device__ __forceinline__ void phase_norm_xs(const Params& p) {
  const float* x = p.in[0];
  const float* g1 = p.in[2];
  const float* mod = (const float*)(p.ws + OFF_MOD);
  const float* mu = p.in[5];
  const int lane = threadIdx.x & 63;
  const int gw = blockIdx.x * NWV + (threadIdx.x >> 6);
  const int nw = gridDim.x * NWV;
  float muv[6][2][8];
#pragma unroll
  for (int ch = 0; ch < 2; ++ch) {
    const int col = (lane + 64 * ch) * 8;
#pragma unroll
    for (int s6 = 0; s6 < 6; ++s6) {
      float4 m0 = *(const float4*)(mu + s6 * DM + col), m1 = *(const float4*)(mu + s6 * DM + col + 4);
      muv[s6][ch][0] = m0.x; muv[s6][ch][1] = m0.y; muv[s6][ch][2] = m0.z; muv[s6][ch][3] = m0.w;
      muv[s6][ch][4] = m1.x; muv[s6][ch][5] = m1.y; muv[s6][ch][6] = m1.z; muv[s6][ch][7] = m1.w;
    }
  }
  auto ldrow = [&](int row, float4* v, float4* u) {
    const bool first = (row & (TT - 1)) == 0;
    const float* xp = x + (size_t)row * DM;
    const float* xq = x + (size_t)(first ? row : row - 1) * DM;
#pragma unroll
    for (int ch = 0; ch < 2; ++ch) {
      const int col = (lane + 64 * ch) * 8;
      v[2 * ch] = *(const float4*)(xp + col); v[2 * ch + 1] = *(const float4*)(xp + col + 4);
      u[2 * ch] = *(const float4*)(xq + col); u[2 * ch + 1] = *(const float4*)(xq + col + 4);
    }
  };
  float4 v[4], u[4];
  int row = gw;
  if (row < MT) ldrow(row, v, u);
  for (; row < MT; row += nw) {
    float4 vn[4], un[4];
    const int rn = row + nw;
    ldrow(rn < MT ? rn : row, vn, un);
    __builtin_amdgcn_sched_barrier(0);
    const bool first = (row & (TT - 1)) == 0;
    float ss = 0.f, st = 0.f;
#pragma unroll
    for (int i = 0; i < 4; ++i) {
      ss += v[i].x * v[i].x + v[i].y * v[i].y + v[i].z * v[i].z + v[i].w * v[i].w;
      st += u[i].x * u[i].x + u[i].y * u[i].y + u[i].z * u[i].z + u[i].w * u[i].w;
    }
    ss = wave_sum(ss); st = wave_sum(st);
    const float rs = rsqrtf(ss * (1.f / DM) + 1e-6f);
    const float rt = first ? 0.f : rsqrtf(st * (1.f / DM) + 1e-6f);
    const float* mb = mod + (size_t)(row >> 13) * MODLD;
#pragma unroll
    for (int ch = 0; ch < 2; ++ch) {
      const int col = (lane + 64 * ch) * 8;
      float4 sh0 = *(const float4*)(mb + col), sh1 = *(const float4*)(mb + col + 4);
      float4 sc0 = *(const float4*)(mb + 1024 + col), sc1 = *(const float4*)(mb + 1024 + col + 4);
      float4 gm0 = *(const float4*)(g1 + col), gm1 = *(const float4*)(g1 + col + 4);
      const float gmv[8] = {gm0.x, gm0.y, gm0.z, gm0.w, gm1.x, gm1.y, gm1.z, gm1.w};
      const float sh[8] = {sh0.x, sh0.y, sh0.z, sh0.w, sh1.x, sh1.y, sh1.z, sh1.w};
      const float sc[8] = {sc0.x, sc0.y, sc0.z, sc0.w, sc1.x, sc1.y, sc1.z, sc1.w};
      const float xv[8] = {v[2 * ch].x, v[2 * ch].y, v[2 * ch].z, v[2 * ch].w, v[2 * ch + 1].x, v[2 * ch + 1].y, v[2 * ch + 1].z, v[2 * ch + 1].w};
      const float uv[8] = {u[2 * ch].x, u[2 * ch].y, u[2 * ch].z, u[2 * ch].w, u[2 * ch + 1].x, u[2 * ch + 1].y, u[2 * ch + 1].z, u[2 * ch + 1].w};
      float h[8], d[8];
#pragma unroll
      for (int e = 0; e < 8; ++e) {
        const float gg = gmv[e] * (1.f + sc[e]);
        h[e] = xv[e] * rs * gg + sh[e];
        const float q = first ? 0.f : (uv[e] * rt * gg + sh[e]);
        d[e] = q - h[e];
      }
#pragma unroll
      for (int s6 = 0; s6 < 6; ++s6) {
        float o[8];
#pragma unroll
        for (int e = 0; e < 8; ++e) o[e] = h[e] + d[e] * muv[s6][ch][e];
        *(uint4*)((u16*)(p.ws + SLOT(s6)) + (size_t)row * DM + col) = pack8(o);
      }
    }
#pragma unroll
    for (int i = 0; i < 4; ++i) { v[i] = vn[i]; u[i] = un[i]; }
  }
}

enum { EPI_BF16 = 0, EPI_TANH, EPI_SIG, EPI_DECAY, EPI_AK, EPI_RESID, EPI_SWIGLU, EPI_HEADNORM, EPI_VT };
struct Epi {
  u16* o16; float* o32; const float* res; const float* gate; int ldo;
  const float* v0; const float* v1; const float* v2;
  u16* kbuf; u16* kkbuf; u16* abbuf;
};

constexpr int G_BK = 64, G_HALF = 128, G_HT = G_HALF * G_BK;

__device__ __forceinline__ int lds_byte(int r, int c) {
  int st = (r >> 4) * 2 + (c >> 5), rr = r & 15, cc = c & 31, ob = rr * 64 + cc * 2;
  return st * 1024 + (ob ^ (((ob >> 9) & 1) << 5));
}
__device__ __forceinline__ void stage_rc(int b, int& R, int& C) {
  int st = b / 1024, sb = b % 1024, swz = sb ^ (((sb >> 9) & 1) << 5);
  R = (st >> 1) * 16 + swz / 64; C = (st & 1) * 32 + (swz % 64) / 2;
}

#define IS(x) ((((EPISET) >> (x)) & 1) && epi == (x))
template <int EPISET>
__device__ __forceinline__ void gemm_tile(const u16* __restrict__ A, const u16* __restrict__ Bt, const int K,
                                          const int brow, const int bcol, const int epi, const Epi& e, unsigned char* smem) {
  u16* shm = (u16*)smem;
#define SA(b, h) (shm + ((b) * 2 + (h)) * G_HT)
#define SB(b, h) (shm + (4 + (b) * 2 + (h)) * G_HT)
#define STAGE(P, BASE, br, kt) do { const char* _gb = (const char*)((BASE) + (long)(br) * K + (long)(kt) * G_BK); \
      __builtin_amdgcn_global_load_lds((const unsigned*)(_gb + (size_t)voff), \
        (__attribute__((address_space(3))) unsigned*)((char*)(P) + threadIdx.x * 16), 16, 0, 0); \
      __builtin_amdgcn_global_load_lds((const unsigned*)(_gb + (size_t)K * 128 + (size_t)voff), \
        (__attribute__((address_space(3))) unsigned*)((char*)(P) + threadIdx.x * 16 + 8192), 16, 0, 0); } while (0)
#define LDA(dst, b, h) for (int m = 0; m < 4; ++m) for (int k = 0; k < 2; ++k) \
    dst[m][k] = *reinterpret_cast<const bf16x8*>((char*)SA(b, h) + lds_byte(wr * 64 + m * 16 + fr, k * 32 + fq * 8))
#define LDB(dst, b, h) for (int n = 0; n < 2; ++n) for (int k = 0; k < 2; ++k) \
    dst[n][k] = *reinterpret_cast<const bf16x8*>((char*)SB(b, h) + lds_byte(wc * 32 + n * 16 + fr, k * 32 + fq * 8))
#define MMA(ai, bj, At_, Bt_) do { __builtin_amdgcn_s_setprio(1); \
    for (int m = 0; m < 4; ++m) for (int n = 0; n < 2; ++n) for (int k = 0; k < 2; ++k) \
      acc[ai][bj][m][n] = __builtin_amdgcn_mfma_f32_16x16x32_bf16(At_[m][k], Bt_[n][k], acc[ai][bj][m][n], 0, 0, 0); \
    __builtin_amdgcn_s_setprio(0); } while (0)
#define WAIT_V(n) asm volatile("s_waitcnt vmcnt(" #n ")" ::: "memory")
#define WAIT_L(n) asm volatile("s_waitcnt lgkmcnt(" #n ")" ::: "memory")
#define BAR __builtin_amdgcn_s_barrier()
#define SCHED __builtin_amdgcn_sched_barrier(0)
  const int tid = threadIdx.x;
  const int wid = tid >> 6, lane = tid & 63, wr = wid >> 2, wc = wid & 3, fr = lane & 15, fq = lane >> 4;
  f32x4 acc[2][2][4][2] = {};
  bf16x8 At[4][2], B0[2][2], B1[2][2];
  int nt = K / G_BK;
  asm volatile("" : "+s"(nt));
  unsigned voff;
  { int _r, _c; stage_rc(tid * 16, _r, _c); voff = (unsigned)(_r * K + _c) * 2u; }
  __syncthreads();
  STAGE(SB(0, 0), Bt, bcol, 0); STAGE(SA(0, 0), A, brow, 0);
  STAGE(SB(0, 1), Bt, bcol + G_HALF, 0); STAGE(SA(0, 1), A, brow + G_HALF, 0);
  if (wr == 1) BAR;
  WAIT_V(4); BAR;
  STAGE(SB(1, 0), Bt, bcol, 1); STAGE(SA(1, 0), A, brow, 1); STAGE(SB(1, 1), Bt, bcol + G_HALF, 1);
  WAIT_V(6); BAR;
#pragma unroll 1
  for (int t = 0; t < nt - 2; t += 2) {
    LDB(B0, 0, 0); SCHED; LDA(At, 0, 0); STAGE(SA(1, 1), A, brow + G_HALF, t + 1);
    WAIT_L(8); BAR; WAIT_L(0); MMA(0, 0, At, B0); BAR; SCHED;
    LDB(B1, 0, 1); STAGE(SB(0, 0), Bt, bcol, t + 2);
    BAR; WAIT_L(0); MMA(0, 1, At, B1); BAR;
    LDA(At, 0, 1); STAGE(SA(0, 0), A, brow, t + 2);
    BAR; WAIT_L(0); MMA(1, 0, At, B0); BAR; SCHED;
    STAGE(SB(0, 1), Bt, bcol + G_HALF, t + 2);
    WAIT_V(6); BAR; MMA(1, 1, At, B1); BAR;
    LDB(B0, 1, 0); SCHED; LDA(At, 1, 0); STAGE(SA(0, 1), A, brow + G_HALF, t + 2);
    WAIT_L(8); BAR; WAIT_L(0); MMA(0, 0, At, B0); BAR; SCHED;
    LDB(B1, 1, 1); STAGE(SB(1, 0), Bt, bcol, t + 3);
    BAR; WAIT_L(0); MMA(0, 1, At, B1); BAR;
    LDA(At, 1, 1); STAGE(SA(1, 0), A, brow, t + 3);
    BAR; WAIT_L(0); MMA(1, 0, At, B0); BAR; SCHED;
    STAGE(SB(1, 1), Bt, bcol + G_HALF, t + 3);
    WAIT_V(6); BAR; MMA(1, 1, At, B1); BAR;
  }
  { LDB(B0, 0, 0); LDA(At, 0, 0); STAGE(SA(1, 1), A, brow + G_HALF, nt - 1);
    BAR; WAIT_L(0); MMA(0, 0, At, B0); BAR;
    LDB(B1, 0, 1); BAR; WAIT_L(0); MMA(0, 1, At, B1); BAR;
    LDA(At, 0, 1); WAIT_V(4); BAR; WAIT_L(0); MMA(1, 0, At, B0); MMA(1, 1, At, B1); BAR; }
  { LDB(B0, 1, 0); LDA(At, 1, 0); WAIT_V(2); BAR; WAIT_L(0); MMA(0, 0, At, B0); BAR;
    LDB(B1, 1, 1); WAIT_V(0); BAR; WAIT_L(0); MMA(0, 1, At, B1); BAR;
    LDA(At, 1, 1); BAR; WAIT_L(0); MMA(1, 0, At, B0); MMA(1, 1, At, B1); BAR; }
  if (wr == 0) BAR;
#undef SA
#undef SB
#undef STAGE
#undef LDA
#undef LDB
#undef MMA
#undef WAIT_V
#undef WAIT_L
#undef BAR
#undef SCHED

  int tid_e;
  asm volatile("v_mov_b32 %0, %1" : "=v"(tid_e) : "v"(tid));
  const int wid_e = tid_e >> 6, lane_e = tid_e & 63, wr_e = wid_e >> 2, wc_e = wid_e & 3, fr_e = lane_e & 15, fq_e = lane_e >> 4;
#pragma unroll
  for (int ai = 0; ai < 2; ++ai)
#pragma unroll
    for (int bj = 0; bj < 2; ++bj) {
      float* stg = (float*)(smem + ((ai * 2 + bj) & 1) * STG_BYTES);
      if (IS(EPI_VT)) {
#pragma unroll
        for (int m = 0; m < 4; ++m)
#pragma unroll
          for (int n = 0; n < 2; ++n) {
            f32x4 a4 = acc[ai][bj][m][n];
            *(float4*)(stg + (wc_e * 32 + n * 16 + fr_e) * STG_LD + wr_e * 64 + m * 16 + fq_e * 4) = make_float4(a4[0], a4[1], a4[2], a4[3]);
          }
      } else {
#pragma unroll
        for (int m = 0; m < 4; ++m)
#pragma unroll
          for (int n = 0; n < 2; ++n)
#pragma unroll
            for (int j = 0; j < 4; ++j)
              stg[(wr_e * 64 + m * 16 + fq_e * 4 + j) * STG_LD + wc_e * 32 + n * 16 + fr_e] = acc[ai][bj][m][n][j];
      }
      __syncthreads();
      const int r0 = brow + ai * 128, c0 = bcol + bj * 128;
      if (IS(EPI_SWIGLU)) {
#pragma unroll
        for (int i = 0; i < 2; ++i) {
          const int item = tid_e + NT * i;
          const int row = item >> 3, o0 = (item & 7) * 8;
          const int gc = (o0 >> 4) * 32 + (o0 & 15);
          const float* sp = stg + row * STG_LD + gc;
          float4 g0 = *(const float4*)(sp), g1 = *(const float4*)(sp + 4);
          float4 u0 = *(const float4*)(sp + 16), u1 = *(const float4*)(sp + 20);
          float o[8] = {siluf_(g0.x) * u0.x, siluf_(g0.y) * u0.y, siluf_(g0.z) * u0.z, siluf_(g0.w) * u0.w,
                        siluf_(g1.x) * u1.x, siluf_(g1.y) * u1.y, siluf_(g1.z) * u1.z, siluf_(g1.w) * u1.w};
          *(uint4*)(e.o16 + (size_t)(r0 + row) * FF + (c0 >> 1) + o0) = pack8(o);
        }
      } else if (IS(EPI_VT)) {
#pragma unroll 1
        for (int i = 0; i < 4; ++i) {
          const int item = tid_e + NT * i;
          const int kg = item & 15, dl = item >> 4;
          const float* sp = stg + dl * STG_LD + kg * 8;
          float4 a = *(const float4*)sp, b4 = *(const float4*)(sp + 4);
          float o[8] = {a.x, a.y, a.z, a.w, b4.x, b4.y, b4.z, b4.w};
          const int tok = r0 + kg * 8;
          const int b = tok >> 13, t = tok & (TT - 1), nblk = t >> 8, key = t & 255;
          const int col = c0 + dl, h = col >> 6, d = col & 63;
          *(uint4*)(e.o16 + ((size_t)(((b * 16 + h) * 32 + nblk) * 64 + d)) * 256 + key) = pack8(o);
        }
      } else {
#pragma unroll 1
        for (int i = 0; i < 4; ++i) {
          const int row = (tid_e >> 4) + 32 * i, cg = tid_e & 15;
          const float* sp = stg + row * STG_LD + cg * 8;
          float4 a = *(const float4*)sp, b4 = *(const float4*)(sp + 4);
          float v[8] = {a.x, a.y, a.z, a.w, b4.x, b4.y, b4.z, b4.w};
          const int grow = r0 + row, gcol = c0 + cg * 8;
          if (IS(EPI_BF16) || IS(EPI_TANH) || IS(EPI_SIG)) {
#pragma unroll
            for (int q = 0; q < 8; ++q) {
              if (IS(EPI_TANH)) v[q] = tanhf_(v[q]);
              if (IS(EPI_SIG)) v[q] = sigmoidf_(v[q]);
            }
            *(uint4*)(e.o16 + (size_t)grow * e.ldo + gcol) = pack8(v);
          } else if (IS(EPI_DECAY)) {
            float4 w0a = *(const float4*)(e.v0 + gcol), w0b = *(const float4*)(e.v0 + gcol + 4);
            float w0[8] = {w0a.x, w0a.y, w0a.z, w0a.w, w0b.x, w0b.y, w0b.z, w0b.w};
            float o[8];
#pragma unroll
            for (int q = 0; q < 8; ++q) {
              o[q] = __expf(-0.60653066f * sigmoidf_(w0[q] + v[q]));
            }
            float* op = e.o32 + (size_t)grow * DM + gcol;
            *(float4*)op = make_float4(o[0], o[1], o[2], o[3]);
            *(float4*)(op + 4) = make_float4(o[4], o[5], o[6], o[7]);
          } else if (IS(EPI_AK)) {
            const size_t off = (size_t)grow * DM + gcol;
            float kv[8]; unpack8(*(const uint4*)(e.kbuf + off), kv);
            float4 t0 = *(const float4*)(e.v0 + gcol), t1 = *(const float4*)(e.v0 + gcol + 4);
            float a0[8] = {t0.x, t0.y, t0.z, t0.w, t1.x, t1.y, t1.z, t1.w};
            t0 = *(const float4*)(e.v1 + gcol); t1 = *(const float4*)(e.v1 + gcol + 4);
            float kkc[8] = {t0.x, t0.y, t0.z, t0.w, t1.x, t1.y, t1.z, t1.w};
            t0 = *(const float4*)(e.v2 + gcol); t1 = *(const float4*)(e.v2 + gcol + 4);
            float kac[8] = {t0.x, t0.y, t0.z, t0.w, t1.x, t1.y, t1.z, t1.w};
            float kkv[8], ss = 0.f;
#pragma unroll
            for (int q = 0; q < 8; ++q) { kkv[q] = kv[q] * kkc[q]; ss += kkv[q] * kkv[q]; }
            ss += __shfl_xor(ss, 1); ss += __shfl_xor(ss, 2); ss += __shfl_xor(ss, 4);
            const float inv = fminf(__builtin_amdgcn_rsqf(ss), 1e12f);
            float o1[8], o2[8], o3[8];
#pragma unroll
            for (int q = 0; q < 8; ++q) {
              const float aa = sigmoidf_(a0[q] + v[q]);
              const float kkn = kkv[q] * inv;
              o1[q] = kv[q] * (1.f + (aa - 1.f) * kac[q]);
              o2[q] = kkn;
              o3[q] = kkn * aa;
            }
            *(uint4*)(e.kbuf + off) = pack8(o1);
            *(uint4*)(e.kkbuf + off) = pack8(o2);
            *(uint4*)(e.abbuf + off) = pack8(o3);
          } else if (IS(EPI_RESID)) {
            const size_t off = (size_t)grow * DM + gcol;
            const float* gp = e.gate + (size_t)(grow >> 13) * MODLD + gcol;
            float rv[8];
            if (e.res) {
              float4 r0v = *(const float4*)(e.res + off), r1v = *(const float4*)(e.res + off + 4);
              rv[0] = r0v.x; rv[1] = r0v.y; rv[2] = r0v.z; rv[3] = r0v.w; rv[4] = r1v.x; rv[5] = r1v.y; rv[6] = r1v.z; rv[7] = r1v.w;
            } else {
              unpack8(*(const uint4*)(e.kbuf + off), rv);
            }
            float4 g0 = *(const float4*)gp, g1 = *(const float4*)(gp + 4);
            const float gg[8] = {g0.x, g0.y, g0.z, g0.w, g1.x, g1.y, g1.z, g1.w};
            float o[8];
#pragma unroll
            for (int q = 0; q < 8; ++q) o[q] = rv[q] + gg[q] * v[q];
            if (e.o32) {
              *(float4*)(e.o32 + off) = make_float4(o[0], o[1], o[2], o[3]);
              *(float4*)(e.o32 + off + 4) = make_float4(o[4], o[5], o[6], o[7]);
            } else {
              *(uint4*)(e.o16 + off) = pack8(o);
            }
          } else if (IS(EPI_HEADNORM)) {
            float ss = 0.f;
#pragma unroll
            for (int q = 0; q < 8; ++q) ss += v[q] * v[q];
            ss += __shfl_xor(ss, 1); ss += __shfl_xor(ss, 2); ss += __shfl_xor(ss, 4);
            const float rs = rsqrtf(ss * (1.f / 64.f) + 1e-6f);
            float4 t0 = *(const float4*)(e.v0 + (gcol & 63)), t1 = *(const float4*)(e.v0 + (gcol & 63) + 4);
            float gn[8] = {t0.x, t0.y, t0.z, t0.w, t1.x, t1.y, t1.z, t1.w};
#pragma unroll
            for (int q = 0; q < 8; ++q) v[q] = v[q] * rs * gn[q];
            *(uint4*)(e.o16 + (size_t)grow * DM + gcol) = pack8(v);
          }
        }
      }
    }
}

__device__ __forceinline__ int tile_remap(int i) {
  const int G = gridDim.x;
  const int b = i % G, r = i / G;
  const int per = G >> 3;
  return r * G + (b & 7) * per + (b >> 3);
}

typedef float v2f __attribute__((ext_vector_type(2)));
constexpr int SC_TC = 16;
constexpr int SC_BUF = 5 * SC_TC * 64 * 4 + SC_TC * 16 * 4;
struct ScanRegs { uint4 a, b; float4 d; uint2 v; };

__device__ __forceinline__ void phase_scan(const Params& p, unsigned char* smem) {
  if (blockIdx.x >= 256) return;
  const int sb = blockIdx.x, bh = sb & 63, rg = sb >> 6;
  const int b = bh >> 4, h = bh & 15;
  const size_t base = (size_t)b * TT * DM + h * 64;
  const u16* Rb = (const u16*)(p.ws + SLOT(6));
  const u16* Kb = (const u16*)DSLOT(p, 0);
  const u16* Vb = (const u16*)DSLOT(p, 1);
  const u16* KKb = (const u16*)(p.ws + SLOT(3));
  const u16* ABb = (const u16*)(p.ws + SLOT(4));
  const float* DECb = (const float*)(p.ws + SLOT(1));
  u16* Yb = (u16*)(p.ws + SLOT(0));
  if (threadIdx.x >= 256) {
    const int tid = threadIdx.x - 256;
    const int ls = (tid & 127) >> 3, lc8 = tid & 7, pair = tid >> 7;
    const u16* pa = (pair ? KKb : Rb) + base + (size_t)ls * DM + lc8 * 8;
    const u16* pb = (pair ? ABb : Kb) + base + (size_t)ls * DM + lc8 * 8;
    const float* pd = DECb + base + (size_t)(tid >> 4) * DM + (tid & 15) * 4;
    const u16* pv = Vb + base + (size_t)((tid & 63) >> 2) * DM + rg * 16 + (tid & 3) * 4;
    auto gload = [&](ScanRegs& R, int t0) {
      const size_t o = (size_t)t0 * DM;
      R.a = *(const uint4*)(pa + o);
      R.b = *(const uint4*)(pb + o);
      R.d = *(const float4*)(pd + o);
      R.v = *(const uint2*)(pv + o);
    };
    auto lstore = [&](const ScanRegs& R, int buf) {
      float* L = (float*)(smem + buf * SC_BUF);
      float* la = L + (pair ? 2 : 0) * (SC_TC * 64) + ls * 64 + lc8 * 8;
      float* lb = L + (pair ? 3 : 1) * (SC_TC * 64) + ls * 64 + lc8 * 8;
      const float sg = pair ? -1.f : 1.f;
      *(float4*)(la) = make_float4(sg * bflo(R.a.x), sg * bfhi(R.a.x), sg * bflo(R.a.y), sg * bfhi(R.a.y));
      *(float4*)(la + 4) = make_float4(sg * bflo(R.a.z), sg * bfhi(R.a.z), sg * bflo(R.a.w), sg * bfhi(R.a.w));
      *(float4*)(lb) = make_float4(bflo(R.b.x), bfhi(R.b.x), bflo(R.b.y), bfhi(R.b.y));
      *(float4*)(lb + 4) = make_float4(bflo(R.b.z), bfhi(R.b.z), bflo(R.b.w), bfhi(R.b.w));
      *(float4*)(L + 4 * (SC_TC * 64) + (tid >> 4) * 64 + (tid & 15) * 4) = R.d;
      if (tid < 64) *(float4*)(L + 5 * (SC_TC * 64) + (tid >> 2) * 16 + (tid & 3) * 4) = make_float4(bflo(R.v.x), bfhi(R.v.x), bflo(R.v.y), bfhi(R.v.y));
    };
    ScanRegs X, Y;
    gload(X, 0);
    lstore(X, 0);
    gload(X, SC_TC);
    gload(Y, 2 * SC_TC);
    __syncthreads();
#pragma unroll 1
    for (int t0 = 0; t0 < TT; t0 += 2 * SC_TC) {
      lstore(X, 1);
      gload(X, min(t0 + 3 * SC_TC, TT - SC_TC));
      __syncthreads();
      lstore(Y, 0);
      gload(Y, min(t0 + 4 * SC_TC, TT - SC_TC));
      __syncthreads();
    }
  } else {
    const int tid = threadIdx.x, w = tid >> 6, lane = tid & 63;
    const int rl = lane >> 4, cl = lane & 15;
    const int row = rg * 16 + w * 4 + rl;
    u16* yp = Yb + base + row + (size_t)cl * DM;
    float S0 = 0.f, S1 = 0.f, S2 = 0.f, S3 = 0.f;
    struct StepIn { float4 r4, k4, n4, b4, d4; float v; };
    auto ldsload = [&](const float* L, int s) {
      StepIn q;
      q.n4 = *(const float4*)(L + 2 * (SC_TC * 64) + s * 64 + cl * 4);
      q.b4 = *(const float4*)(L + 3 * (SC_TC * 64) + s * 64 + cl * 4);
      q.d4 = *(const float4*)(L + 4 * (SC_TC * 64) + s * 64 + cl * 4);
      q.k4 = *(const float4*)(L + 1 * (SC_TC * 64) + s * 64 + cl * 4);
      q.v = L[5 * (SC_TC * 64) + s * 16 + w * 4 + rl];
      q.r4 = *(const float4*)(L + 0 * (SC_TC * 64) + s * 64 + cl * 4);
      return q;
    };
    float rp0 = 0.f, rp1 = 0.f, rp2 = 0.f, rp3 = 0.f;
    float yacc = 0.f;
    auto step = [&](const StepIn& c) -> float {
      float t0, t1, y0, y1, u0, u1, u2, u3;
      asm volatile(
          "v_mul_f32 %0, %8, %12\n\t"
          "v_mul_f32 %2, %8, %16\n\t"
          "v_mul_f32 %1, %10, %14\n\t"
          "v_mul_f32 %3, %10, %18\n\t"
          "v_fmac_f32 %0, %9, %13\n\t"
          "v_fmac_f32 %2, %9, %17\n\t"
          "v_fmac_f32 %1, %11, %15\n\t"
          "v_fmac_f32 %3, %11, %19\n\t"
          "v_add_f32 %0, %0, %1\n\t"
          "v_add_f32 %2, %2, %3\n\t"
          "v_mul_f32 %4, %20, %21\n\t"
          "v_add_f32_dpp %0, %0, %0 quad_perm:[1,0,3,2] row_mask:0xf bank_mask:0xf bound_ctrl:1\n\t"
          "v_add_f32_dpp %2, %2, %2 quad_perm:[1,0,3,2] row_mask:0xf bank_mask:0xf bound_ctrl:1\n\t"
          "v_mul_f32 %5, %20, %22\n\t"
          "v_add_f32_dpp %0, %0, %0 quad_perm:[2,3,0,1] row_mask:0xf bank_mask:0xf bound_ctrl:1\n\t"
          "v_add_f32_dpp %2, %2, %2 quad_perm:[2,3,0,1] row_mask:0xf bank_mask:0xf bound_ctrl:1\n\t"
          "v_mul_f32 %6, %20, %23\n\t"
          "v_add_f32_dpp %0, %0, %0 row_ror:4 row_mask:0xf bank_mask:0xf bound_ctrl:1\n\t"
          "v_add_f32_dpp %2, %2, %2 row_ror:4 row_mask:0xf bank_mask:0xf bound_ctrl:1\n\t"
          "v_mul_f32 %7, %20, %24\n\t"
          "v_add_f32_dpp %0, %0, %0 row_ror:8 row_mask:0xf bank_mask:0xf bound_ctrl:1\n\t"
          "v_add_f32_dpp %2, %2, %2 row_ror:8 row_mask:0xf bank_mask:0xf bound_ctrl:1\n\t"
          : "=&v"(t0), "=&v"(t1), "=&v"(y0), "=&v"(y1), "=&v"(u0), "=&v"(u1), "=&v"(u2), "=&v"(u3)
          : "v"(S0), "v"(S1), "v"(S2), "v"(S3), "v"(c.n4.x), "v"(c.n4.y), "v"(c.n4.z), "v"(c.n4.w),
            "v"(rp0), "v"(rp1), "v"(rp2), "v"(rp3), "v"(c.v), "v"(c.k4.x), "v"(c.k4.y), "v"(c.k4.z), "v"(c.k4.w));
      asm volatile(
          "v_fmac_f32 %4, %8, %9\n\t"
          "v_fmac_f32 %5, %8, %10\n\t"
          "v_fmac_f32 %6, %8, %11\n\t"
          "v_fmac_f32 %7, %8, %12\n\t"
          "v_fma_f32 %0, %0, %13, %4\n\t"
          "v_fma_f32 %1, %1, %14, %5\n\t"
          "v_fma_f32 %2, %2, %15, %6\n\t"
          "v_fma_f32 %3, %3, %16, %7\n\t"
          : "+v"(S0), "+v"(S1), "+v"(S2), "+v"(S3), "+v"(u0), "+v"(u1), "+v"(u2), "+v"(u3)
          : "v"(t0), "v"(c.b4.x), "v"(c.b4.y), "v"(c.b4.z), "v"(c.b4.w), "v"(c.d4.x), "v"(c.d4.y), "v"(c.d4.z), "v"(c.d4.w));
      rp0 = c.r4.x; rp1 = c.r4.y; rp2 = c.r4.z; rp3 = c.r4.w;
      return y0;
    };
    auto compute = [&](int buf, int t0) {
      const float* L = (const float*)(smem + buf * SC_BUF);
      StepIn cur = ldsload(L, 0);
#pragma unroll
      for (int s = 0; s < SC_TC; ++s) {
        StepIn nxt = cur;
        if (s + 1 < SC_TC) nxt = ldsload(L, s + 1);
        const float y = step(cur);
        if (s == 0) {
          yacc = (cl == 15) ? y : yacc;
          if (t0 > 0) yp[(size_t)(t0 - SC_TC) * DM] = f2bf(yacc);
        } else {
          yacc = (cl == s - 1) ? y : yacc;
        }
        cur = nxt;
        if ((s & 3) == 3) __builtin_amdgcn_sched_barrier(0);
      }
    };
    __syncthreads();
#pragma unroll 1
    for (int t0 = 0; t0 < TT; t0 += 2 * SC_TC) {
      compute(0, t0);
      __syncthreads();
      compute(1, t0 + SC_TC);
      __syncthreads();
    }
    {
      float y = (S0 * rp0 + S1 * rp1) + (S2 * rp2 + S3 * rp3);
      y = allreduce16(y);
      yacc = (cl == 15) ? y : yacc;
      yp[(size_t)(TT - SC_TC) * DM] = f2bf(yacc);
    }
  }
}

__device__ __forceinline__ void phase_gn(const Params& p) {
  const u16* R = (const u16*)(p.ws + SLOT(6));
  const u16* Kp = (const u16*)DSLOT(p, 0);
  const u16* V = (const u16*)DSLOT(p, 1);
  const u16* G = (const u16*)(p.ws + SLOT(5));
  u16* Y = (u16*)(p.ws + SLOT(0));
  const float* rk = p.in[17];
  const float* lg = p.in[18];
  const float* lb = p.in[19];
  const size_t nchunks = (size_t)MT * 128;
  const size_t stride = (size_t)gridDim.x * NT;
  for (size_t q = (size_t)blockIdx.x * NT + threadIdx.x; q < nchunks; q += stride) {
    const size_t off = q * 8;
    const int c = (int)(off & (DM - 1));
    float y[8], r[8], k[8], v[8], g[8];
    unpack8(*(const uint4*)(Y + off), y); unpack8(*(const uint4*)(R + off), r); unpack8(*(const uint4*)(Kp + off), k);
    unpack8(*(const uint4*)(V + off), v); unpack8(*(const uint4*)(G + off), g);
    float s = 0.f, rks = 0.f;
#pragma unroll
    for (int i = 0; i < 8; ++i) { s += y[i]; rks += r[i] * k[i] * rk[c + i]; }
    s += __shfl_xor(s, 1); s += __shfl_xor(s, 2); s += __shfl_xor(s, 4);
    rks += __shfl_xor(rks, 1); rks += __shfl_xor(rks, 2); rks += __shfl_xor(rks, 4);
    const float mean = s * (1.f / 64.f);
    float vs = 0.f;
#pragma unroll
    for (int i = 0; i < 8; ++i) { float d = y[i] - mean; vs += d * d; }
    vs += __shfl_xor(vs, 1); vs += __shfl_xor(vs, 2); vs += __shfl_xor(vs, 4);
    const float rstd = rsqrtf(vs * (1.f / 64.f) + 64e-5f);
    float z[8];
#pragma unroll
    for (int i = 0; i < 8; ++i) z[i] = ((y[i] - mean) * rstd * lg[c + i] + lb[c + i] + rks * v[i]) * g[i];
    *(uint4*)(Y + off) = pack8(z);
  }
}

__device__ __forceinline__ void phase_kmean(const Params& p) {
  const u16* Kb = (const u16*)(p.ws + SLOT(1));
  float* km = (float*)(p.ws + OFF_KMEAN);
  const int lane = threadIdx.x & 63;
  const int gw = blockIdx.x * NWV + (threadIdx.x >> 6), nw = gridDim.x * NWV;
  for (int it = gw; it < 2048; it += nw) {
    const int bh = it >> 5, n = it & 31, b = bh >> 4, h = bh & 15;
    const u16* kp = Kb + ((size_t)b * TT + n * 256 + (lane >> 3)) * DM + h * 64 + (lane & 7) * 8;
    float s[8] = {0.f, 0.f, 0.f, 0.f, 0.f, 0.f, 0.f, 0.f};
#pragma unroll 8
    for (int j = 0; j < 32; ++j) {
      float f[8]; unpack8(*(const uint4*)(kp + (size_t)j * 8 * DM), f);
#pragma unroll
      for (int q = 0; q < 8; ++q) s[q] += f[q];
    }
#pragma unroll
    for (int q = 0; q < 8; ++q) { s[q] += __shfl_xor(s[q], 8); s[q] += __shfl_xor(s[q], 16); s[q] += __shfl_xor(s[q], 32); }
    if (lane < 8) {
      float* o = km + (size_t)it * 64 + lane * 8;
      *(float4*)o = make_float4(s[0] * (1.f / 256.f), s[1] * (1.f / 256.f), s[2] * (1.f / 256.f), s[3] * (1.f / 256.f));
      *(float4*)(o + 4) = make_float4(s[4] * (1.f / 256.f), s[5] * (1.f / 256.f), s[6] * (1.f / 256.f), s[7] * (1.f / 256.f));
    }
  }
}

__device__ __forceinline__ void phase_gate(const Params& p) {
  const u16* Q = (const u16*)(p.ws + SLOT(4));
  const float* km = (const float*)(p.ws + OFF_KMEAN);
  int* cnt = (int*)(p.ws + OFF_CNT);
  u16* lists = (u16*)(p.ws + SLOT(5));
  float* lse = (float*)(p.ws + OFF_LSE);
  const int lane = threadIdx.x & 63;
  const int gw = blockIdx.x * NWV + (threadIdx.x >> 6), nw = gridDim.x * NWV;
  for (int it0 = gw; it0 < 8192; it0 += nw) {
    const int it = __builtin_amdgcn_readfirstlane(it0);
    const int bh = it >> 7, qg = it & 127, b = bh >> 4, h = bh & 15;
    const int blk = qg >> 2;
    const int t = qg * 64 + lane;
    const size_t m = (size_t)b * TT + t;
    float q[64];
    {
      const uint4* qp = (const uint4*)(Q + m * DM + h * 64);
#pragma unroll
      for (int i = 0; i < 8; ++i) unpack8(qp[i], q + 8 * i);
    }
    float s0 = -3e38f, s1 = -3e38f, s2 = -3e38f;
    int i0 = 0, i1 = 0, i2 = 0;
    for (int n = 0; n < blk; ++n) {
      const float* kr = km + ((size_t)bh * 32 + n) * 64;
      float s = 0.f;
#pragma unroll
      for (int d = 0; d < 64; ++d) s += q[d] * kr[d];
      if (s > s0) { s2 = s1; i2 = i1; s1 = s0; i1 = i0; s0 = s; i0 = n; }
      else if (s > s1) { s2 = s1; i2 = i1; s1 = s; i1 = n; }
      else if (s > s2) { s2 = s; i2 = n; }
    }
    const int nsel = min(3, blk);
    unsigned long long mymask = 0ull;
    for (int n = 0; n < blk; ++n) {
      const bool sel = (i0 == n) || (nsel > 1 && i1 == n) || (nsel > 2 && i2 == n);
      const unsigned long long mk = __ballot(sel);
      if (lane == n) mymask = mk;
    }
    const int tot = __popcll(mymask);
    int base = 0;
    if (lane < blk && tot > 0) base = atomicAdd(&cnt[bh * 32 + lane], tot);
    const unsigned mlo = (unsigned)mymask, mhi = (unsigned)(mymask >> 32);
    const unsigned long long below = (1ull << lane) - 1ull;
#pragma unroll
    for (int s = 0; s < 3; ++s) {
      const int n = (s == 0) ? i0 : (s == 1) ? i1 : i2;
      const unsigned lo = __shfl(mlo, n), hi = __shfl(mhi, n);
      const int bs = __shfl(base, n);
      if (s < nsel) {
        const unsigned long long mk = ((unsigned long long)hi << 32) | lo;
        const int pos = bs + __popcll(mk & below);
        lists[(size_t)(bh * 32 + n) * 8192 + pos] = (u16)(t | (s << 13));
      } else {
        lse[(size_t)s * MT * 16 + m * 16 + h] = -1e30f;
      }
    }
  }
}

constexpr int VT_LD = 528;
__device__ __forceinline__ int swz(int row, int chunk) { return row * 128 + ((chunk ^ ((row >> 1) & 7)) << 4); }

template <bool OWN>
__device__ __forceinline__ void attn_tile(const bf16x8 q0, const bf16x8 q1, int tloc, const unsigned char* smem,
                                          float& mout, float& lout, f32x4 O[4]) {
  const int lane = threadIdx.x & 63, g = lane >> 4, c16 = lane & 15;
  f32x4 S[16];
#pragma unroll
  for (int kt = 0; kt < 16; ++kt) {
    const int row = kt * 16 + c16;
    bf16x8 k0 = *(const bf16x8*)(smem + swz(row, g));
    bf16x8 k1 = *(const bf16x8*)(smem + swz(row, g + 4));
    f32x4 z = (f32x4){0.f, 0.f, 0.f, 0.f};
    z = __builtin_amdgcn_mfma_f32_16x16x32_bf16(k0, q0, z, 0, 0, 0);
    z = __builtin_amdgcn_mfma_f32_16x16x32_bf16(k1, q1, z, 0, 0, 0);
    S[kt] = z;
    if ((kt & 3) == 3) __builtin_amdgcn_sched_barrier(0);
  }
  float mx = -3e38f;
#pragma unroll
  for (int kt = 0; kt < 16; ++kt)
#pragma unroll
    for (int r = 0; r < 4; ++r) {
      float s = S[kt][r] * (0.125f * 1.44269504f);
      if (OWN) { if (kt * 16 + 4 * g + r > tloc) s = -3e38f; }
      S[kt][r] = s;
      mx = fmaxf(mx, s);
    }
  mx = fmaxf(mx, __shfl_xor(mx, 16));
  mx = fmaxf(mx, __shfl_xor(mx, 32));
  float l = 0.f;
#pragma unroll
  for (int kt = 0; kt < 16; ++kt)
#pragma unroll
    for (int r = 0; r < 4; ++r) {
      float pv = __builtin_amdgcn_exp2f(S[kt][r] - mx);
      S[kt][r] = pv;
      l += pv;
    }
  l += __shfl_xor(l, 16);
  l += __shfl_xor(l, 32);
#pragma unroll
  for (int dt = 0; dt < 4; ++dt) O[dt] = (f32x4){0.f, 0.f, 0.f, 0.f};
  const unsigned char* vb = smem + 32768;
#pragma unroll
  for (int j = 0; j < 8; ++j) {
    union { bf16x8 v; unsigned u[4]; } pf;
    pf.u[0] = pack2(S[2 * j][0], S[2 * j][1]);
    pf.u[1] = pack2(S[2 * j][2], S[2 * j][3]);
    pf.u[2] = pack2(S[2 * j + 1][0], S[2 * j + 1][1]);
    pf.u[3] = pack2(S[2 * j + 1][2], S[2 * j + 1][3]);
#pragma unroll
    for (int dt = 0; dt < 4; ++dt) {
      const unsigned char* vp = vb + (dt * 16 + c16) * VT_LD + (32 * j + 4 * g) * 2;
      union { bf16x8 v; uint2 h[2]; } vf;
      vf.h[0] = *(const uint2*)(vp);
      vf.h[1] = *(const uint2*)(vp + 32);
      O[dt] = __builtin_amdgcn_mfma_f32_16x16x32_bf16(vf.v, pf.v, O[dt], 0, 0, 0);
    }
    if (j & 1) __builtin_amdgcn_sched_barrier(0);
  }
  mout = mx * 0.69314718f; lout = l;
}

__device__ __forceinline__ u16* part_ptr(const Params& p, int slot) {
  return (u16*)(p.ws + (slot == 0 ? SLOT(0) : slot == 1 ? SLOT(3) : SLOT(6)));
}

struct AItem { int li, seg, b, h, n, c; };

template <bool OWN>
__device__ __forceinline__ void phase_attn(const Params& p, unsigned char* smem) {
  const int tid = threadIdx.x, lane = tid & 63, w = tid >> 6, g = lane >> 4, c16 = lane & 15;
  const int G = gridDim.x;
  const int* cnt = (const int*)(p.ws + OFF_CNT);
  const u16* lists = (const u16*)(p.ws + SLOT(5));
  u16* Q = (u16*)(p.ws + SLOT(4));
  float* lse = (float*)(p.ws + OFF_LSE);
  int* offs = (int*)(smem + 66560);
  unsigned char* Qs = smem + 75008;
  unsigned* entl = (unsigned*)(smem + 75008 + 16384);
  int total = 4096;
  if (!OWN) {
    int* part = (int*)smem;
    int loc[4]; int s = 0;
#pragma unroll
    for (int i = 0; i < 4; ++i) { loc[i] = (cnt[tid * 4 + i] + 127) >> 7; s += loc[i]; }
    part[tid] = s;
    __syncthreads();
    if (tid == 0) { int a = 0; for (int i = 0; i < NT; ++i) { int v = part[i]; part[i] = a; a += v; } offs[2048] = a; }
    __syncthreads();
    int a = part[tid];
#pragma unroll
    for (int i = 0; i < 4; ++i) { offs[tid * 4 + i] = a; a += loc[i]; }
    __syncthreads();
    total = offs[2048];
  }
  const int Jp = (total + G - 1) / G;
  const int it0 = (int)blockIdx.x * Jp;
  if (it0 >= total) return;
  const int J = min(Jp, total - it0);
  int* itab = (int*)(smem + 75008 + 16384 + 512);
  int* ctab = itab + 1024;
  if (!OWN) {
    for (int j = tid; j < J; j += NT) {
      const int it_ = it0 + j;
      int lo = 0, hi = 2048;
      while (hi - lo > 1) { int mid = (lo + hi) >> 1; if (offs[mid] <= it_) lo = mid; else hi = mid; }
      itab[j] = lo | ((it_ - offs[lo]) << 11);
      ctab[j] = cnt[lo];
    }
    __syncthreads();
  }

  auto decode = [&](int j) {
    AItem d;
    if (OWN) { const int it = it0 + j; d.li = it >> 1; d.seg = it & 1; d.c = 0; }
    else {
      const int pk = itab[j];
      d.li = pk & 2047; d.seg = pk >> 11; d.c = ctab[j];
    }
    const int bh = d.li >> 5;
    d.n = d.li & 31; d.b = bh >> 4; d.h = bh & 15;
    return d;
  };
  auto load_ent1 = [&](const AItem& d, const int i) -> unsigned {
    const int row = (tid >> 3) + 64 * i;
    if (OWN) return (unsigned)(d.n * 256 + d.seg * 128 + row) | 0x8000u;
    const int qi = d.seg * 128 + row;
    const int qc = min(qi, 8191);
    unsigned v = lists[(size_t)d.li * 8192 + qc];
    return (qi < d.c) ? (v | 0x8000u) : 0u;
  };
  uint4 kr0, kr1, kr2, kr3, vr0, vr1, vr2, vr3, qr0, qr1;
  auto load_kvq = [&](const AItem& d, const unsigned e0, const unsigned e1, const bool ldkv) {
    const u16* Kb = (const u16*)(p.ws + SLOT(1)) + ((size_t)d.b * TT + d.n * 256) * DM + d.h * 64;
    const u16* Vt = (const u16*)(p.ws + SLOT(2)) + (size_t)(((d.b * 16 + d.h) * 32 + d.n) * 64) * 256;
#define LDKV(i, K_, V_) { const int idx = tid + NT * (i); K_ = *(const uint4*)(Kb + (size_t)(idx >> 3) * DM + (idx & 7) * 8); V_ = *(const uint4*)(Vt + (size_t)idx * 8); }
    if (ldkv) { LDKV(0, kr0, vr0) LDKV(1, kr1, vr1) LDKV(2, kr2, vr2) LDKV(3, kr3, vr3) }
#undef LDKV
    qr0 = *(const uint4*)(Q + ((size_t)d.b * TT + (e0 & 8191u)) * DM + d.h * 64 + (tid & 7) * 8);
    qr1 = *(const uint4*)(Q + ((size_t)d.b * TT + (e1 & 8191u)) * DM + d.h * 64 + (tid & 7) * 8);
  };
  auto store_lds = [&](const unsigned e0, const unsigned e1, const bool stkv) {
#define STKV(i, K_, V_) { const int idx = tid + NT * (i); *(uint4*)(smem + swz(idx >> 3, idx & 7)) = K_; *(uint4*)(smem + 32768 + (idx >> 5) * VT_LD + (idx & 31) * 16) = V_; }
    if (stkv) { STKV(0, kr0, vr0) STKV(1, kr1, vr1) STKV(2, kr2, vr2) STKV(3, kr3, vr3) }
#undef STKV
    *(uint4*)(Qs + swz(tid >> 3, tid & 7)) = qr0;
    *(uint4*)(Qs + swz((tid >> 3) + 64, tid & 7)) = qr1;
    if ((tid & 7) == 0) { entl[tid >> 3] = e0; entl[(tid >> 3) + 64] = e1; }
  };

  int it = 0;
  AItem dc = decode(0);
  unsigned ec0 = load_ent1(dc, 0), ec1 = load_ent1(dc, 1);
  load_kvq(dc, ec0, ec1, true);
  bool newkv = true;
  int itn = min(1, J - 1);
  AItem dn = decode(itn);
  unsigned en0 = load_ent1(dn, 0), en1 = load_ent1(dn, 1);
  while (true) {
    __syncthreads();
    store_lds(ec0, ec1, newkv);
    __syncthreads();
    newkv = (dn.li != dc.li);
    load_kvq(dn, en0, en1, newkv);
    ec0 = en0; ec1 = en1;
    const AItem d = dc;
    dc = dn;
    itn = min(itn + 1, J - 1);
    dn = decode(itn);
    en0 = load_ent1(dn, 0); en1 = load_ent1(dn, 1);
    {
      const int row = w * 16 + c16;
      const unsigned ent = entl[row];
      const bool valid = (ent >> 15) != 0;
      const int t = ent & 8191, slot = (ent >> 13) & 3;
      const size_t m = (size_t)d.b * TT + t;
      const bf16x8 q0 = *(const bf16x8*)(Qs + swz(row, g));
      const bf16x8 q1 = *(const bf16x8*)(Qs + swz(row, g + 4));
      float mx, l; f32x4 O[4];
      attn_tile<OWN>(q0, q1, d.seg * 128 + row, smem, mx, l, O);
      if (!OWN) {
        if (valid) {
          const float inv = frcp_(l);
          u16* po = part_ptr(p, slot) + m * DM + d.h * 64;
#pragma unroll
          for (int dt = 0; dt < 4; ++dt) {
            uint2 o;
            o.x = pack2(O[dt][0] * inv, O[dt][1] * inv);
            o.y = pack2(O[dt][2] * inv, O[dt][3] * inv);
            *(uint2*)(po + dt * 16 + 4 * g) = o;
          }
          if (g == 0) lse[(size_t)slot * MT * 16 + m * 16 + d.h] = mx + __logf(l);
        }
      } else {
        float ls[3], M2 = mx;
#pragma unroll
        for (int s = 0; s < 3; ++s) { ls[s] = lse[(size_t)s * MT * 16 + m * 16 + d.h]; M2 = fmaxf(M2, ls[s]); }
        const float wo = __expf(mx - M2);
        float ws[3], den = l * wo;
#pragma unroll
        for (int s = 0; s < 3; ++s) { ws[s] = (ls[s] > -1e29f) ? __expf(ls[s] - M2) : 0.f; den += ws[s]; }
        const float inv = frcp_(den);
#pragma unroll
        for (int dt = 0; dt < 4; ++dt) {
          float o0 = O[dt][0] * wo, o1 = O[dt][1] * wo, o2 = O[dt][2] * wo, o3 = O[dt][3] * wo;
#pragma unroll
          for (int s = 0; s < 3; ++s) {
            if (ws[s] != 0.f) {
              const u16* pp = part_ptr(p, s) + m * DM + d.h * 64 + dt * 16 + 4 * g;
              uint2 u = *(const uint2*)pp;
              o0 += ws[s] * bflo(u.x); o1 += ws[s] * bfhi(u.x); o2 += ws[s] * bflo(u.y); o3 += ws[s] * bfhi(u.y);
            }
          }
          uint2 o;
          o.x = pack2(o0 * inv, o1 * inv);
          o.y = pack2(o2 * inv, o3 * inv);
          *(uint2*)(Q + m * DM + d.h * 64 + dt * 16 + 4 * g) = o;
        }
      }
    }
    it += 1;
    if (it >= J) break;
  }
}

#define TILE_LOOP(total) for (int _i = blockIdx.x, _G = gridDim.x, _tot = (total), _end = ((_tot + _G - 1) / _G) * _G; _i < _end; _i += _G)

#define EB(x) (1 << (x))
__device__ __forceinline__ void phase_rkv(const Params& p, unsigned char* smem) {
  const u16* wt = (const u16*)p.ws;
  TILE_LOOP(1536) {
    const int tile = tile_remap(_i);
    if (tile >= 1536) continue;
    const int s = tile >> 9, rem = tile & 511, mt = rem >> 2, nt = rem & 3;
    Epi e{};
    e.o16 = (s == 0) ? (u16*)(p.ws + SLOT(6)) : (u16*)DSLOT(p, s - 1); e.ldo = DM;
    gemm_tile<EB(EPI_BF16)>((const u16*)(p.ws + SLOT(s)), wt + WT_RKV + (size_t)s * M1, DM, mt * 256, nt * 256, EPI_BF16, e, smem);
  }
}

__device__ __forceinline__ void phase_lora1(const Params& p, unsigned char* smem) {
  const u16* wt = (const u16*)p.ws;
  u16* lora = (u16*)(p.ws + SLOT(0));
  TILE_LOOP(384) {
    const int tile = _i;
    if (tile >= 384) continue;
    const int j = tile >> 7, mt = tile & 127;
    Epi e{};
    e.o16 = lora + (size_t)j * MT * 256; e.ldo = 256;
    const u16* A = (const u16*)(p.ws + SLOT(3 + j));
    const u16* B = wt + WT_W1 + (size_t)j * 256 * 1024;
    const int epi = (j == 0) ? EPI_TANH : (j == 1) ? EPI_BF16 : EPI_SIG;
    gemm_tile<EB(EPI_TANH) | EB(EPI_BF16) | EB(EPI_SIG)>(A, B, DM, mt * 256, 0, epi, e, smem);
  }
}

__device__ __forceinline__ void phase_lora2(const Params& p, unsigned char* smem) {
  const u16* wt = (const u16*)p.ws;
  const u16* lora = (const u16*)(p.ws + SLOT(0));
  TILE_LOOP(1536) {
    const int tile = tile_remap(_i);
    if (tile >= 1536) continue;
    const int which = tile >> 9, rem = tile & 511, mt = rem >> 2, nt = rem & 3;
    Epi e{};
    e.o32 = (float*)(p.ws + SLOT(1));
    e.v0 = (which == 0) ? p.in[7] : p.in[10]; e.v1 = p.in[15]; e.v2 = p.in[16];
    e.kbuf = (u16*)DSLOT(p, 0); e.kkbuf = (u16*)(p.ws + SLOT(3)); e.abbuf = (u16*)(p.ws + SLOT(4));
    e.o16 = (u16*)(p.ws + SLOT(5)); e.ldo = DM;
    const int epi = (which == 0) ? EPI_DECAY : (which == 1) ? EPI_AK : EPI_BF16;
    gemm_tile<EB(EPI_DECAY) | EB(EPI_AK) | EB(EPI_BF16)>(lora + (size_t)which * MT * 256, wt + WT_W2 + (size_t)which * 256 * 1024, 256,
                                                        mt * 256, nt * 256, epi, e, smem);
  }
}

__device__ __forceinline__ void phase_resid(const Params& p, const u16* A, int K, const u16* Bt, const float* res32, const u16* res16,
                                            float* out32, u16* out16, int gate_off, unsigned char* smem) {
  const float* mod = (const float*)(p.ws + OFF_MOD);
  TILE_LOOP(512) {
    const int tile = tile_remap(_i);
    if (tile >= 512) continue;
    const int mt = tile >> 2, nt = tile & 3;
    Epi e{};
    e.o32 = out32; e.o16 = out16; e.res = res32; e.kbuf = (u16*)res16; e.gate = mod + gate_off;
    gemm_tile<EB(EPI_RESID)>(A, Bt, K, mt * 256, nt * 256, EPI_RESID, e, smem);
  }
}

__device__ __forceinline__ void phase_ffn_up(const Params& p, const u16* A, const u16* Bt, u16* act, unsigned char* smem) {
  TILE_LOOP(128 * 22) {
    const int tile = tile_remap(_i);
    if (tile >= 128 * 22) continue;
    const int st = tile >> 5, w = tile & 31;
    int mt2, nt2;
    if (st < 80) { mt2 = (st / 5) * 8 + (w >> 2); nt2 = (st % 5) * 4 + (w & 3); }
    else { mt2 = (st - 80) * 16 + (w >> 1); nt2 = 20 + (w & 1); }
    Epi e{};
    e.o16 = act;
    gemm_tile<EB(EPI_SWIGLU)>(A, Bt, DM, mt2 * 256, nt2 * 256, EPI_SWIGLU, e, smem);
  }
}

__device__ __forceinline__ void phase_qkv(const Params& p, unsigned char* smem) {
  const u16* wt = (const u16*)p.ws;
  TILE_LOOP(1536) {
    const int tile = tile_remap(_i);
    if (tile >= 1536) continue;
    const int which = tile >> 9, rem = tile & 511, mt = rem >> 2, nt = rem & 3;
    Epi e{};
    e.o16 = (u16*)(p.ws + (which == 0 ? SLOT(1) : which == 1 ? SLOT(2) : SLOT(4)));
    e.v0 = (which == 0) ? p.in[29] : p.in[31];
    const u16* A = (const u16*)(p.ws + (which == 2 ? SLOT(3) : SLOT(0)));
    const u16* B = wt + WT_KVK + (size_t)which * M1;
    const int epi = (which == 1) ? EPI_VT : EPI_HEADNORM;
    gemm_tile<EB(EPI_HEADNORM) | EB(EPI_VT)>(A, B, DM, mt * 256, nt * 256, epi, e, smem);
  }
}

constexpr int NPHASES = 21;
#ifdef ONLY_PHASE
#define PEN(k) ((k) == ONLY_PHASE)
#else
#define PEN(k) true
#endif
#define RUN(k, call) if (ph0 <= (k) && (k) < ph1) { if (PEN(k)) { call; } if ((k) + 1 < ph1) grid.sync(); }

__global__ void __launch_bounds__(512, 2) mega(Params p, int ph0, int ph1) {
  __shared__ __attribute__((aligned(16))) unsigned char smem[SMEM_BYTES];
  cg::grid_group grid = cg::this_grid();
  const float* mod = (const float*)(p.ws + OFF_MOD);
  const u16* wt = (const u16*)p.ws;
  RUN(0, phase_prep(p, smem))
  RUN(1, phase_norm_xs(p))
  RUN(2, phase_rkv(p, smem))
  RUN(3, phase_lora1(p, smem))
  RUN(4, phase_lora2(p, smem))
  RUN(5, phase_scan(p, smem))
  RUN(6, phase_gn(p))
  RUN(7, phase_resid(p, (const u16*)(p.ws + SLOT(0)), DM, wt + WT_WO, p.in[0], nullptr, nullptr, (u16*)(p.ws + SLOT(1)), 2048, smem))
  RUN(8, phase_norm((const u16*)(p.ws + SLOT(1)), p.in[2] + 1024, mod, 3072, 3072 + 1024, (u16*)(p.ws + SLOT(3)), nullptr, 0, 0, nullptr))
  RUN(9, phase_ffn_up(p, (const u16*)(p.ws + SLOT(3)), wt + WT_GU, (u16*)(p.ws + SLOT(4)), smem))
  RUN(10, phase_resid(p, (const u16*)(p.ws + SLOT(4)), FF, wt + WT_DN, nullptr, (const u16*)(p.ws + SLOT(1)), nullptr, (u16*)DSLOT(p, 0), 3072 + 2048, smem))
  RUN(11, phase_norm((const u16*)DSLOT(p, 0), p.in[24], mod, 12288, 12288 + 1024, (u16*)(p.ws + SLOT(0)), p.in[2] + 2048, 6144, 6144 + 1024, (u16*)(p.ws + SLOT(3))))
  RUN(12, phase_qkv(p, smem))
  RUN(13, phase_kmean(p))
  RUN(14, phase_gate(p))
  RUN(15, phase_attn<false>(p, smem))
  RUN(16, phase_attn<true>(p, smem))
  RUN(17, phase_resid(p, (const u16*)(p.ws + SLOT(4)), DM, wt + WT_MBO, nullptr, (const u16*)DSLOT(p, 0), nullptr, (u16*)(p.ws + SLOT(5)), 6144 + 2048, smem))
  RUN(18, phase_norm((const u16*)(p.ws + SLOT(5)), p.in[2] + 3072, mod, 9216, 9216 + 1024, (u16*)(p.ws + SLOT(0)), nullptr, 0, 0, nullptr))
  RUN(19, phase_ffn_up(p, (const u16*)(p.ws + SLOT(0)), wt + WT_GU + (size_t)5632 * 1024, (u16*)(p.ws + SLOT(1)), smem))
  RUN(20, phase_resid(p, (const u16*)(p.ws + SLOT(1)), FF, wt + WT_DN + (size_t)1024 * 2816, nullptr, (const u16*)(p.ws + SLOT(5)), p.out, nullptr, 9216 + 2048, smem))
}

extern "C" void kernel_launch(void* const* d_in, const int* in_sizes, int n_in, void* d_out, int out_size,
                              void* d_ws, size_t ws_size, hipStream_t stream) {
  static int grid_blocks = 0;
  if (!grid_blocks) {
    int dev = 0, cus = 0, per_cu = 0;
    (void)hipGetDevice(&dev);
    (void)hipDeviceGetAttribute(&cus, hipDeviceAttributeMultiprocessorCount, dev);
    (void)hipOccupancyMaxActiveBlocksPerMultiprocessor(&per_cu, mega, NT, 0);
    if (per_cu < 1) per_cu = 1;
    grid_blocks = cus;
    if (grid_blocks > cus * per_cu) grid_blocks = cus * per_cu;
    grid_blocks &= ~7;
  }
  Params p{};
  for (int i = 0; i < 33; ++i) p.in[i] = (const float*)d_in[i];
  p.out = (float*)d_out;
  p.ws = (unsigned char*)d_ws;
#if SINGLE_LAUNCH
  int ph0 = 0, ph1 = NPHASES;
  void* args[] = {&p, &ph0, &ph1};
  hipError_t e = hipLaunchCooperativeKernel((void*)mega, dim3(grid_blocks), dim3(NT), args, 0, stream);
  if (e != hipSuccess) fprintf(stderr, "cooperative launch failed: %s (grid %d)\n", hipGetErrorString(e), grid_blocks);
#else
  for (int ph = 0; ph < NPHASES; ++ph) mega<<<grid_blocks, NT, 0, stream>>>(p, ph, ph + 1);
#endif
}
```

```cpp
#include <hip/hip_runtime.h>
#include <hip/hip_cooperative_groups.h>
#include <cstdio>
namespace cg = cooperative_groups;

typedef unsigned short u16;
typedef __attribute__((ext_vector_type(8))) short bf16x8;
typedef __attribute__((ext_vector_type(4))) float f32x4;

#ifndef SINGLE_LAUNCH
#define SINGLE_LAUNCH 1
#endif

constexpr int NT = 512;
constexpr int NWV = 8;
constexpr int DM = 1024, NB = 4, TT = 8192, MT = NB * TT, FF = 2816, NH = 16;
constexpr int MODLD = 14336;
constexpr size_t MiB = 1u << 20;
constexpr size_t M1 = 1048576;

constexpr size_t WT_RKV = 0;
constexpr size_t WT_W1 = WT_RKV + 3 * M1;
constexpr size_t WT_A1 = WT_W1 + 256 * 1024;
constexpr size_t WT_G1 = WT_A1 + 256 * 1024;
constexpr size_t WT_W2 = WT_G1 + 256 * 1024;
constexpr size_t WT_A2 = WT_W2 + 256 * 1024;
constexpr size_t WT_G2 = WT_A2 + 256 * 1024;
constexpr size_t WT_WO = WT_G2 + 256 * 1024;
constexpr size_t WT_GU = WT_WO + M1;
constexpr size_t WT_DN = WT_GU + 2 * 5632 * 1024;
constexpr size_t WT_KVK = WT_DN + 2 * 1024 * 2816;
constexpr size_t WT_KVV = WT_KVK + M1;
constexpr size_t WT_Q = WT_KVV + M1;
constexpr size_t WT_MBO = WT_Q + M1;
constexpr size_t WT_END = WT_MBO + M1;
static_assert(WT_END * 2 <= 52 * MiB, "wt region");
constexpr size_t OFF_MOD = 52 * MiB;
constexpr size_t OFF_CNT = OFF_MOD + 4 * MODLD * 4;
constexpr size_t OFF_KMEAN = OFF_CNT + 2048 * 4;
constexpr size_t OFF_LSE = 53 * MiB;
constexpr size_t OFF_SLOT0 = 64 * MiB;
#define SLOT(i) (OFF_SLOT0 + (size_t)(i) * 64 * MiB)
#define DSLOT(p, i) ((unsigned char*)(p).out + (size_t)(i) * 64 * MiB)

constexpr int STG_LD = 132;
constexpr int STG_BYTES = 128 * STG_LD * 4;
constexpr int SMEM_BYTES = 163840;

struct Params {
  const float* in[33];
  float* out;
  unsigned char* ws;
};

typedef __bf16 bf2v __attribute__((ext_vector_type(2)));
typedef float f2v __attribute__((ext_vector_type(2)));
__device__ __forceinline__ unsigned pack2(float a, float b) {
  f2v f = {a, b};
  bf2v r = __builtin_convertvector(f, bf2v);
  return __builtin_bit_cast(unsigned, r);
}
__device__ __forceinline__ u16 f2bf(float f) { return (u16)(pack2(f, 0.f) & 0xffffu); }
__device__ __forceinline__ float bf2f(u16 h) { return __uint_as_float(((unsigned)h) << 16); }
__device__ __forceinline__ float bflo(unsigned x) { return __uint_as_float(x << 16); }
__device__ __forceinline__ float bfhi(unsigned x) { return __uint_as_float(x & 0xffff0000u); }
__device__ __forceinline__ float frcp_(float x) { return __builtin_amdgcn_rcpf(x); }
__device__ __forceinline__ float sigmoidf_(float x) { return frcp_(1.f + __expf(-x)); }
__device__ __forceinline__ float siluf_(float x) { return x * frcp_(1.f + __expf(-x)); }
__device__ __forceinline__ float tanhf_(float x) { return 1.f - 2.f * frcp_(1.f + __expf(2.f * x)); }

template <int CTRL>
__device__ __forceinline__ float dppf(float x) {
  return __int_as_float(__builtin_amdgcn_update_dpp(0, __float_as_int(x), CTRL, 0xF, 0xF, true));
}
__device__ __forceinline__ float allreduce16(float x) {
  x += dppf<0xB1>(x);
  x += dppf<0x4E>(x);
  x += dppf<0x124>(x);
  x += dppf<0x128>(x);
  return x;
}
__device__ __forceinline__ float wave_sum(float x) {
#pragma unroll
  for (int o = 32; o >= 1; o >>= 1) x += __shfl_xor(x, o);
  return x;
}

__device__ __forceinline__ void unpack8(uint4 u, float* f) {
  f[0] = bflo(u.x); f[1] = bfhi(u.x); f[2] = bflo(u.y); f[3] = bfhi(u.y);
  f[4] = bflo(u.z); f[5] = bfhi(u.z); f[6] = bflo(u.w); f[7] = bfhi(u.w);
}
__device__ __forceinline__ uint4 pack8(const float* f) {
  uint4 o; o.x = pack2(f[0], f[1]); o.y = pack2(f[2], f[3]); o.z = pack2(f[4], f[5]); o.w = pack2(f[6], f[7]); return o;
}

struct TJob { const float* src; u16* dst; int K, N, Kp, Np, mode, which; };

__device__ __forceinline__ TJob get_job(const Params& p, int j) {
  u16* wt = (u16*)p.ws;
  TJob t;
  t.mode = 0; t.which = 0;
  switch (j) {
    case 0: t.src = p.in[6]; t.dst = wt + WT_RKV; t.K = 1024; t.N = 1024; t.Kp = 1024; t.Np = 1024; break;
    case 1: t.src = p.in[6] + M1; t.dst = wt + WT_RKV + M1; t.K = 1024; t.N = 1024; t.Kp = 1024; t.Np = 1024; break;
    case 2: t.src = p.in[6] + 2 * M1; t.dst = wt + WT_RKV + 2 * M1; t.K = 1024; t.N = 1024; t.Kp = 1024; t.Np = 1024; break;
    case 3: t.src = p.in[8]; t.dst = wt + WT_W1; t.K = 1024; t.N = 64; t.Kp = 1024; t.Np = 256; break;
    case 4: t.src = p.in[11]; t.dst = wt + WT_A1; t.K = 1024; t.N = 64; t.Kp = 1024; t.Np = 256; break;
    case 5: t.src = p.in[13]; t.dst = wt + WT_G1; t.K = 1024; t.N = 160; t.Kp = 1024; t.Np = 256; break;
    case 6: t.src = p.in[9]; t.dst = wt + WT_W2; t.K = 64; t.N = 1024; t.Kp = 256; t.Np = 1024; break;
    case 7: t.src = p.in[12]; t.dst = wt + WT_A2; t.K = 64; t.N = 1024; t.Kp = 256; t.Np = 1024; break;
    case 8: t.src = p.in[14]; t.dst = wt + WT_G2; t.K = 160; t.N = 1024; t.Kp = 256; t.Np = 1024; break;
    case 9: t.src = p.in[20]; t.dst = wt + WT_WO; t.K = 1024; t.N = 1024; t.Kp = 1024; t.Np = 1024; break;
    case 10: t.src = p.in[21]; t.dst = wt + WT_GU; t.K = 1024; t.N = 2816; t.Kp = 1024; t.Np = 2816; t.mode = 1; t.which = 0; break;
    case 11: t.src = p.in[22]; t.dst = wt + WT_GU; t.K = 1024; t.N = 2816; t.Kp = 1024; t.Np = 2816; t.mode = 1; t.which = 1; break;
    case 12: t.src = p.in[21] + (size_t)1024 * 2816; t.dst = wt + WT_GU + (size_t)5632 * 1024; t.K = 1024; t.N = 2816; t.Kp = 1024; t.Np = 2816; t.mode = 1; t.which = 0; break;
    case 13: t.src = p.in[22] + (size_t)1024 * 2816; t.dst = wt + WT_GU + (size_t)5632 * 1024; t.K = 1024; t.N = 2816; t.Kp = 1024; t.Np = 2816; t.mode = 1; t.which = 1; break;
    case 14: t.src = p.in[23]; t.dst = wt + WT_DN; t.K = 2816; t.N = 1024; t.Kp = 2816; t.Np = 1024; break;
    case 15: t.src = p.in[23] + (size_t)1024 * 2816; t.dst = wt + WT_DN + (size_t)1024 * 2816; t.K = 2816; t.N = 1024; t.Kp = 2816; t.Np = 1024; break;
    case 16: t.src = p.in[27]; t.dst = wt + WT_KVK; t.K = 1024; t.N = 1024; t.Kp = 1024; t.Np = 1024; break;
    case 17: t.src = p.in[28]; t.dst = wt + WT_KVV; t.K = 1024; t.N = 1024; t.Kp = 1024; t.Np = 1024; break;
    case 18: t.src = p.in[30]; t.dst = wt + WT_Q; t.K = 1024; t.N = 1024; t.Kp = 1024; t.Np = 1024; break;
    default: t.src = p.in[32]; t.dst = wt + WT_MBO; t.K = 1024; t.N = 1024; t.Kp = 1024; t.Np = 1024; break;
  }
  return t;
}
constexpr int NJOBS = 20;

__device__ __forceinline__ void phase_prep(const Params& p, unsigned char* smem) {
  const int tid = threadIdx.x;
  if (blockIdx.x == 0) {
    int* cnt = (int*)(p.ws + OFF_CNT);
    for (int i = tid; i < 2048; i += NT) cnt[i] = 0;
  }
  int total = 0;
  for (int j = 0; j < NJOBS; ++j) { TJob t = get_job(p, j); total += (t.Np >> 6) * (t.Kp >> 6); }
  float (*tile)[65] = (float (*)[65])smem;
  const int NADA = MODLD / 64;
  auto decode_tile = [&](int it_, TJob& t, int& n0, int& k0) {
    int j = 0, lt = it_;
    t = get_job(p, 0);
    while (true) {
      int n = (t.Np >> 6) * (t.Kp >> 6);
      if (lt < n) break;
      lt -= n; ++j; t = get_job(p, j);
    }
    const int nkt = t.Kp >> 6;
    n0 = (lt / nkt) * 64; k0 = (lt % nkt) * 64;
  };
  auto tile_load = [&](const TJob& t, int n0, int k0, float4& v0, float4& v1) {
    {
      const int kk = tid >> 4, n4 = (tid & 15) * 4;
      const int k = k0 + kk, n = n0 + n4;
      v0 = make_float4(0.f, 0.f, 0.f, 0.f);
      if (k < t.K && n < t.N) v0 = *(const float4*)(t.src + (size_t)k * t.N + n);
    }
    {
      const int kk = (tid + NT) >> 4, n4 = (tid & 15) * 4;
      const int k = k0 + kk, n = n0 + n4;
      v1 = make_float4(0.f, 0.f, 0.f, 0.f);
      if (k < t.K && n < t.N) v1 = *(const float4*)(t.src + (size_t)k * t.N + n);
    }
  };
  int it = blockIdx.x;
  {
    TJob t; int n0 = 0, k0 = 0; float4 v0, v1;
    if (it < total) { decode_tile(it, t, n0, k0); tile_load(t, n0, k0, v0, v1); }
    while (it < total) {
      {
        const int kk = tid >> 4, n4 = (tid & 15) * 4;
        tile[kk][n4] = v0.x; tile[kk][n4 + 1] = v0.y; tile[kk][n4 + 2] = v0.z; tile[kk][n4 + 3] = v0.w;
        tile[kk + 32][n4] = v1.x; tile[kk + 32][n4 + 1] = v1.y; tile[kk + 32][n4 + 2] = v1.z; tile[kk + 32][n4 + 3] = v1.w;
      }
      __syncthreads();
      const int itn = it + gridDim.x;
      TJob tn = t; int n0n = n0, k0n = k0;
      if (itn < total) { decode_tile(itn, tn, n0n, k0n); tile_load(tn, n0n, k0n, v0, v1); }
      {
        const int nn = tid >> 3, kk0 = (tid & 7) * 8;
        const int n = n0 + nn;
        const int drow = t.mode ? ((n >> 4) * 32 + t.which * 16 + (n & 15)) : n;
        float f[8];
#pragma unroll
        for (int q = 0; q < 8; ++q) f[q] = tile[kk0 + q][nn];
        *(uint4*)(t.dst + (size_t)drow * t.Kp + k0 + kk0) = pack8(f);
      }
      __syncthreads();
      t = tn; n0 = n0n; k0 = k0n; it = itn;
    }
  }
  for (; it < total + NADA; it += gridDim.x) {
    {
      const int a = it - total;
      const int ncol0 = a * 64;
      const float* W; const float* bias; int ldw, nl0;
      if (ncol0 < 12288) {
        int g = ncol0 / 3072;
        W = p.in[3] + (size_t)g * 1024 * 3072; bias = p.in[4] + g * 3072; ldw = 3072; nl0 = ncol0 - g * 3072;
      } else {
        W = p.in[25]; bias = p.in[26]; ldw = 2048; nl0 = ncol0 - 12288;
      }
      float* sc = (float*)smem;
      float* red = (float*)(smem + 16384);
      const float* c = p.in[1];
      for (int i = tid; i < 4096; i += NT) sc[i] = siluf_(c[i]);
      __syncthreads();
      const int w = tid >> 6, lane = tid & 63;
      float a0 = 0, a1 = 0, a2 = 0, a3 = 0;
      const float* wp = W + (size_t)(w * 128) * ldw + nl0 + lane;
#pragma unroll 8
      for (int k = 0; k < 128; ++k) {
        float wv = wp[(size_t)k * ldw];
        int kk = w * 128 + k;
        a0 += sc[kk] * wv; a1 += sc[1024 + kk] * wv; a2 += sc[2048 + kk] * wv; a3 += sc[3072 + kk] * wv;
      }
      red[(w * 4 + 0) * 64 + lane] = a0; red[(w * 4 + 1) * 64 + lane] = a1;
      red[(w * 4 + 2) * 64 + lane] = a2; red[(w * 4 + 3) * 64 + lane] = a3;
      __syncthreads();
      if (tid < 256) {
        int b = tid >> 6;
        float s = 0.f;
#pragma unroll
        for (int ww = 0; ww < 8; ++ww) s += red[(ww * 4 + b) * 64 + lane];
        float* mod = (float*)(p.ws + OFF_MOD);
        mod[b * MODLD + ncol0 + lane] = s + bias[nl0 + lane];
      }
      __syncthreads();
    }
  }
}

__device__ __forceinline__ void phase_norm(const u16* __restrict__ x, const float* __restrict__ g1, const float* __restrict__ mod,
                           int sh1, int sc1, u16* __restrict__ o1,
                           const float* __restrict__ g2, int sh2, int sc2, u16* __restrict__ o2) {
  const int lane = threadIdx.x & 63;
  const int gw = blockIdx.x * NWV + (threadIdx.x >> 6);
  const int nw = gridDim.x * NWV;
  for (int row = gw; row < MT; row += nw) {
    const uint2* xp = (const uint2*)(x + (size_t)row * DM);
    float4 v[4];
    float ss = 0.f;
#pragma unroll
    for (int i = 0; i < 4; ++i) {
      const uint2 t = xp[lane + 64 * i];
      v[i] = make_float4(bflo(t.x), bfhi(t.x), bflo(t.y), bfhi(t.y));
      ss += v[i].x * v[i].x + v[i].y * v[i].y + v[i].z * v[i].z + v[i].w * v[i].w;
    }
    ss = wave_sum(ss);
    const float rs = rsqrtf(ss * (1.f / DM) + 1e-6f);
    const int b = row >> 13;
    const float* mb = mod + (size_t)b * MODLD;
#pragma unroll
    for (int i = 0; i < 4; ++i) {
      const int c = (lane + 64 * i) * 4;
      float4 gg = *(const float4*)(g1 + c);
      float4 sh = *(const float4*)(mb + sh1 + c);
      float4 sc = *(const float4*)(mb + sc1 + c);
      uint2 o;
      o.x = pack2(v[i].x * rs * gg.x * (1.f + sc.x) + sh.x, v[i].y * rs * gg.y * (1.f + sc.y) + sh.y);
      o.y = pack2(v[i].z * rs * gg.z * (1.f + sc.z) + sh.z, v[i].w * rs * gg.w * (1.f + sc.w) + sh.w);
      *(uint2*)(o1 + (size_t)row * DM + c) = o;
      if (o2) {
        float4 gg2 = *(const float4*)(g2 + c);
        float4 sh_ = *(const float4*)(mb + sh2 + c);
        float4 sc_ = *(const float4*)(mb + sc2 + c);
        uint2 q;
        q.x = pack2(v[i].x * rs * gg2.x * (1.f + sc_.x) + sh_.x, v[i].y * rs * gg2.y * (1.f + sc_.y) + sh_.y);
        q.y = pack2(v[i].z * rs * gg2.z * (1.f + sc_.z) + sh_.z, v[i].w * rs * gg2.w * (1.f + sc_.w) + sh_.w);
        *(uint2*)(o2 + (size_t)row * DM + c) = q;
      }
    }
  }
}

__device__ __forceinline__ void phase_norm_xs(const Params& p) {
  const float* x = p.in[0];
  const float* g1 = p.in[2];
  const float* mod = (const float*)(p.ws + OFF_MOD);
  const float* mu = p.in[5];
  const int lane = threadIdx.x & 63;
  const int gw = blockIdx.x * NWV + (threadIdx.x >> 6);
  const int nw = gridDim.x * NWV;
  float muv[6][2][8];
#pragma unroll
  for (int ch = 0; ch < 2; ++ch) {
    const int col = (lane + 64 * ch) * 8;
#pragma unroll
    for (int s6 = 0; s6 < 6; ++s6) {
      float4 m0 = *(const float4*)(mu + s6 * DM + col), m1 = *(const float4*)(mu + s6 * DM + col + 4);
      muv[s6][ch][0] = m0.x; muv[s6][ch][1] = m0.y; muv[s6][ch][2] = m0.z; muv[s6][ch][3] = m0.w;
      muv[s6][ch][4] = m1.x; muv[s6][ch][5] = m1.y; muv[s6][ch][6] = m1.z; muv[s6][ch][7] = m1.w;
    }
  }
  auto ldrow = [&](int row, float4* v, float4* u) {
    const bool first = (row & (TT - 1)) == 0;
    const float* xp = x + (size_t)row * DM;
    const float* xq = x + (size_t)(first ? row : row - 1) * DM;
#pragma unroll
    for (int ch = 0; ch < 2; ++ch) {
      const int col = (lane + 64 * ch) * 8;
      v[2 * ch] = *(const float4*)(xp + col); v[2 * ch + 1] = *(const float4*)(xp + col + 4);
      u[2 * ch] = *(const float4*)(xq + col); u[2 * ch + 1] = *(const float4*)(xq + col + 4);
    }
  };
  float4 v[4], u[4];
  int row = gw;
  if (row < MT) ldrow(row, v, u);
  for (; row < MT; row += nw) {
    float4 vn[4], un[4];
    const int rn = row + nw;
    ldrow(rn < MT ? rn : row, vn, un);
    __builtin_amdgcn_sched_barrier(0);
    const bool first = (row & (TT - 1)) == 0;
    float ss = 0.f, st = 0.f;
#pragma unroll
    for (int i = 0; i < 4; ++i) {
      ss += v[i].x * v[i].x + v[i].y * v[i].y + v[i].z * v[i].z + v[i].w * v[i].w;
      st += u[i].x * u[i].x + u[i].y * u[i].y + u[i].z * u[i].z + u[i].w * u[i].w;
    }
    ss = wave_sum(ss); st = wave_sum(st);
    const float rs = rsqrtf(ss * (1.f / DM) + 1e-6f);
    const float rt = first ? 0.f : rsqrtf(st * (1.f / DM) + 1e-6f);
    const float* mb = mod + (size_t)(row >> 13) * MODLD;
#pragma unroll
    for (int ch = 0; ch < 2; ++ch) {
      const int col = (lane + 64 * ch) * 8;
      float4 sh0 = *(const float4*)(mb + col), sh1 = *(const float4*)(mb + col + 4);
      float4 sc0 = *(const float4*)(mb + 1024 + col), sc1 = *(const float4*)(mb + 1024 + col + 4);
      float4 gm0 = *(const float4*)(g1 + col), gm1 = *(const float4*)(g1 + col + 4);
      const float gmv[8] = {gm0.x, gm0.y, gm0.z, gm0.w, gm1.x, gm1.y, gm1.z, gm1.w};
      const float sh[8] = {sh0.x, sh0.y, sh0.z, sh0.w, sh1.x, sh1.y, sh1.z, sh1.w};
      const float sc[8] = {sc0.x, sc0.y, sc0.z, sc0.w, sc1.x, sc1.y, sc1.z, sc1.w};
      const float xv[8] = {v[2 * ch].x, v[2 * ch].y, v[2 * ch].z, v[2 * ch].w, v[2 * ch + 1].x, v[2 * ch + 1].y, v[2 * ch + 1].z, v[2 * ch + 1].w};
      const float uv[8] = {u[2 * ch].x, u[2 * ch].y, u[2 * ch].z, u[2 * ch].w, u[2 * ch + 1].x, u[2 * ch + 1].y, u[2 * ch + 1].z, u[2 * ch + 1].w};
      float h[8], d[8];
#pragma unroll
      for (int e = 0; e < 8; ++e) {
        const float gg = gmv[e] * (1.f + sc[e]);
        h[e] = xv[e] * rs * gg + sh[e];
        const float q = first ? 0.f : (uv[e] * rt * gg + sh[e]);
        d[e] = q - h[e];
      }
#pragma unroll
      for (int s6 = 0; s6 < 6; ++s6) {
        float o[8];
#pragma unroll
        for (int e = 0; e < 8; ++e) o[e] = h[e] + d[e] * muv[s6][ch][e];
        *(uint4*)((u16*)(p.ws + SLOT(s6)) + (size_t)row * DM + col) = pack8(o);
      }
    }
#pragma unroll
    for (int i = 0; i < 4; ++i) { v[i] = vn[i]; u[i] = un[i]; }
  }
}

enum { EPI_BF16 = 0, EPI_TANH, EPI_SIG, EPI_DECAY, EPI_AK, EPI_RESID, EPI_SWIGLU, EPI_HEADNORM, EPI_VT };
struct Epi {
  u16* o16; float* o32; const float* res; const float* gate; int ldo;
  const float* v0; const float* v1; const float* v2;
  u16* kbuf; u16* kkbuf; u16* abbuf;
};

constexpr int G_BK = 64, G_HALF = 128, G_HT = G_HALF * G_BK;

__device__ __forceinline__ int lds_byte(int r, int c) {
  int st = (r >> 4) * 2 + (c >> 5), rr = r & 15, cc = c & 31, ob = rr * 64 + cc * 2;
  return st * 1024 + (ob ^ (((ob >> 9) & 1) << 5));
}
__device__ __forceinline__ void stage_rc(int b, int& R, int& C) {
  int st = b / 1024, sb = b % 1024, swz = sb ^ (((sb >> 9) & 1) << 5);
  R = (st >> 1) * 16 + swz / 64; C = (st & 1) * 32 + (swz % 64) / 2;
}

#define IS(x) ((((EPISET) >> (x)) & 1) && epi == (x))
template <int EPISET, bool PF = false>
__device__ __forceinline__ void gemm_tile(const u16* __restrict__ A, const u16* __restrict__ Bt, const int K,
                                          const int brow, const int bcol, const int epi, const Epi& e, unsigned char* smem,
                                          const bool pf_first = true, const bool pf_next = false,
                                          const u16* nA = nullptr, const u16* nBt = nullptr, const int nbrow = 0, const int nbcol = 0) {
  u16* shm = (u16*)smem;
#define SA(b, h) (shm + ((b) * 2 + (h)) * G_HT)
#define SB(b, h) (shm + (4 + (b) * 2 + (h)) * G_HT)
#define STAGE(P, BASE, br, kt) do { const char* _gb = (const char*)((BASE) + (long)(br) * K + (long)(kt) * G_BK); \
      __builtin_amdgcn_global_load_lds((const unsigned*)(_gb + (size_t)voff), \
        (__attribute__((address_space(3))) unsigned*)((char*)(P) + threadIdx.x * 16), 16, 0, 0); \
      __builtin_amdgcn_global_load_lds((const unsigned*)(_gb + (size_t)K * 128 + (size_t)voff), \
        (__attribute__((address_space(3))) unsigned*)((char*)(P) + threadIdx.x * 16 + 8192), 16, 0, 0); } while (0)
#define LDA(dst, b, h) for (int m = 0; m < 4; ++m) for (int k = 0; k < 2; ++k) \
    dst[m][k] = *reinterpret_cast<const bf16x8*>((char*)SA(b, h) + lds_byte(wr * 64 + m * 16 + fr, k * 32 + fq * 8))
#define LDB(dst, b, h) for (int n = 0; n < 2; ++n) for (int k = 0; k < 2; ++k) \
    dst[n][k] = *reinterpret_cast<const bf16x8*>((char*)SB(b, h) + lds_byte(wc * 32 + n * 16 + fr, k * 32 + fq * 8))
#define MMA(ai, bj, At_, Bt_) do { __builtin_amdgcn_s_setprio(1); \
    for (int m = 0; m < 4; ++m) for (int n = 0; n < 2; ++n) for (int k = 0; k < 2; ++k) \
      acc[ai][bj][m][n] = __builtin_amdgcn_mfma_f32_16x16x32_bf16(At_[m][k], Bt_[n][k], acc[ai][bj][m][n], 0, 0, 0); \
    __builtin_amdgcn_s_setprio(0); } while (0)
#define WAIT_V(n) asm volatile("s_waitcnt vmcnt(" #n ")" ::: "memory")
#define WAIT_L(n) asm volatile("s_waitcnt lgkmcnt(" #n ")" ::: "memory")
#define BAR __builtin_amdgcn_s_barrier()
#define SCHED __builtin_amdgcn_sched_barrier(0)
  const int tid = threadIdx.x;
  const int wid = tid >> 6, lane = tid & 63, wr = wid >> 2, wc = wid & 3, fr = lane & 15, fq = lane >> 4;
  f32x4 acc[2][2][4][2] = {};
  bf16x8 At[4][2], B0[2][2], B1[2][2];
  int nt = K / G_BK;
  asm volatile("" : "+s"(nt));
  unsigned voff;
  { int _r, _c; stage_rc(tid * 16, _r, _c); voff = (unsigned)(_r * K + _c) * 2u; }
  if (!PF || pf_first) {
    __syncthreads();
    STAGE(SB(0, 0), Bt, bcol, 0); STAGE(SA(0, 0), A, brow, 0);
    STAGE(SB(0, 1), Bt, bcol + G_HALF, 0); STAGE(SA(0, 1), A, brow + G_HALF, 0);
  } else {
    WAIT_L(0); BAR;
  }
  if (wr == 1) BAR;
  WAIT_V(4); BAR;
  STAGE(SB(1, 0), Bt, bcol, 1); STAGE(SA(1, 0), A, brow, 1); STAGE(SB(1, 1), Bt, bcol + G_HALF, 1);
  WAIT_V(6); BAR;
#pragma unroll 1
  for (int t = 0; t < nt - 2; t += 2) {
    LDB(B0, 0, 0); SCHED; LDA(At, 0, 0); STAGE(SA(1, 1), A, brow + G_HALF, t + 1);
    WAIT_L(8); BAR; WAIT_L(0); MMA(0, 0, At, B0); BAR; SCHED;
    LDB(B1, 0, 1); STAGE(SB(0, 0), Bt, bcol, t + 2);
    BAR; WAIT_L(0); MMA(0, 1, At, B1); BAR;
    LDA(At, 0, 1); STAGE(SA(0, 0), A, brow, t + 2);
    BAR; WAIT_L(0); MMA(1, 0, At, B0); BAR; SCHED;
    STAGE(SB(0, 1), Bt, bcol + G_HALF, t + 2);
    WAIT_V(6); BAR; MMA(1, 1, At, B1); BAR;
    LDB(B0, 1, 0); SCHED; LDA(At, 1, 0); STAGE(SA(0, 1), A, brow + G_HALF, t + 2);
    WAIT_L(8); BAR; WAIT_L(0); MMA(0, 0, At, B0); BAR; SCHED;
    LDB(B1, 1, 1); STAGE(SB(1, 0), Bt, bcol, t + 3);
    BAR; WAIT_L(0); MMA(0, 1, At, B1); BAR;
    LDA(At, 1, 1); STAGE(SA(1, 0), A, brow, t + 3);
    BAR; WAIT_L(0); MMA(1, 0, At, B0); BAR; SCHED;
    STAGE(SB(1, 1), Bt, bcol + G_HALF, t + 3);
    WAIT_V(6); BAR; MMA(1, 1, At, B1); BAR;
  }
  { LDB(B0, 0, 0); LDA(At, 0, 0); STAGE(SA(1, 1), A, brow + G_HALF, nt - 1);
    BAR; WAIT_L(0); MMA(0, 0, At, B0); BAR;
    LDB(B1, 0, 1); BAR; WAIT_L(0); MMA(0, 1, At, B1); BAR;
    LDA(At, 0, 1); WAIT_V(4); BAR; WAIT_L(0); MMA(1, 0, At, B0); MMA(1, 1, At, B1); BAR; }
  { LDB(B0, 1, 0); LDA(At, 1, 0); WAIT_V(2); BAR; WAIT_L(0); MMA(0, 0, At, B0); BAR;
    LDB(B1, 1, 1); WAIT_V(0); BAR; WAIT_L(0); MMA(0, 1, At, B1); BAR;
    LDA(At, 1, 1); BAR; WAIT_L(0); MMA(1, 0, At, B0); MMA(1, 1, At, B1); BAR; }
  if (wr == 0) BAR;

  int tid_e;
  asm volatile("v_mov_b32 %0, %1" : "=v"(tid_e) : "v"(tid));
  const int wid_e = tid_e >> 6, lane_e = tid_e & 63, wr_e = wid_e >> 2, wc_e = wid_e & 3, fr_e = lane_e & 15, fq_e = lane_e >> 4;
#pragma unroll
  for (int ai = 0; ai < 2; ++ai)
#pragma unroll
    for (int bj = 0; bj < 2; ++bj) {
      const bool lastq = PF && (ai * 2 + bj) == 3;
      float* stg = lastq ? (float*)(smem + 98304) : (float*)(smem + ((ai * 2 + bj) & 1) * STG_BYTES);
      const int LD = lastq ? 128 : STG_LD;
      if (IS(EPI_VT)) {
#pragma unroll
        for (int m = 0; m < 4; ++m)
#pragma unroll
          for (int n = 0; n < 2; ++n) {
            f32x4 a4 = acc[ai][bj][m][n];
            *(float4*)(stg + (wc_e * 32 + n * 16 + fr_e) * LD + wr_e * 64 + m * 16 + fq_e * 4) = make_float4(a4[0], a4[1], a4[2], a4[3]);
          }
      } else {
#pragma unroll
        for (int m = 0; m < 4; ++m)
#pragma unroll
          for (int n = 0; n < 2; ++n)
#pragma unroll
            for (int j = 0; j < 4; ++j)
              stg[(wr_e * 64 + m * 16 + fq_e * 4 + j) * LD + wc_e * 32 + n * 16 + fr_e] = acc[ai][bj][m][n][j];
      }
      __syncthreads();
      if (lastq && pf_next) {
        STAGE(SB(0, 0), nBt, nbcol, 0); STAGE(SA(0, 0), nA, nbrow, 0);
        STAGE(SB(0, 1), nBt, nbcol + G_HALF, 0); STAGE(SA(0, 1), nA, nbrow + G_HALF, 0);
      }
      const int r0 = brow + ai * 128, c0 = bcol + bj * 128;
      if (IS(EPI_SWIGLU)) {
#pragma unroll
        for (int i = 0; i < 2; ++i) {
          const int item = tid_e + NT * i;
          const int row = item >> 3, o0 = (item & 7) * 8;
          const int gc = (o0 >> 4) * 32 + (o0 & 15);
          const float* sp = stg + row * LD + gc;
          float4 g0 = *(const float4*)(sp), g1 = *(const float4*)(sp + 4);
          float4 u0 = *(const float4*)(sp + 16), u1 = *(const float4*)(sp + 20);
          float o[8] = {siluf_(g0.x) * u0.x, siluf_(g0.y) * u0.y, siluf_(g0.z) * u0.z, siluf_(g0.w) * u0.w,
                        siluf_(g1.x) * u1.x, siluf_(g1.y) * u1.y, siluf_(g1.z) * u1.z, siluf_(g1.w) * u1.w};
          *(uint4*)(e.o16 + (size_t)(r0 + row) * FF + (c0 >> 1) + o0) = pack8(o);
        }
      } else if (IS(EPI_VT)) {
#pragma unroll 1
        for (int i = 0; i < 4; ++i) {
          const int item = tid_e + NT * i;
          const int kg = item & 15, dl = item >> 4;
          const float* sp = stg + dl * LD + kg * 8;
          float4 a = *(const float4*)sp, b4 = *(const float4*)(sp + 4);
          float o[8] = {a.x, a.y, a.z, a.w, b4.x, b4.y, b4.z, b4.w};
          const int tok = r0 + kg * 8;
          const int b = tok >> 13, t = tok & (TT - 1), nblk = t >> 8, key = t & 255;
          const int col = c0 + dl, h = col >> 6, d = col & 63;
          *(uint4*)(e.o16 + ((size_t)(((b * 16 + h) * 32 + nblk) * 64 + d)) * 256 + key) = pack8(o);
        }
      } else {
#pragma unroll 1
        for (int i = 0; i < 4; ++i) {
          const int row = (tid_e >> 4) + 32 * i, cg = tid_e & 15;
          const float* sp = stg + row * LD + cg * 8;
          float4 a = *(const float4*)sp, b4 = *(const float4*)(sp + 4);
          float v[8] = {a.x, a.y, a.z, a.w, b4.x, b4.y, b4.z, b4.w};
          const int grow = r0 + row, gcol = c0 + cg * 8;
          if (IS(EPI_BF16) || IS(EPI_TANH) || IS(EPI_SIG)) {
#pragma unroll
            for (int q = 0; q < 8; ++q) {
              if (IS(EPI_TANH)) v[q] = tanhf_(v[q]);
              if (IS(EPI_SIG)) v[q] = sigmoidf_(v[q]);
            }
            *(uint4*)(e.o16 + (size_t)grow * e.ldo + gcol) = pack8(v);
          } else if (IS(EPI_DECAY)) {
            float4 w0a = *(const float4*)(e.v0 + gcol), w0b = *(const float4*)(e.v0 + gcol + 4);
            float w0[8] = {w0a.x, w0a.y, w0a.z, w0a.w, w0b.x, w0b.y, w0b.z, w0b.w};
            float o[8];
#pragma unroll
            for (int q = 0; q < 8; ++q) {
              o[q] = __expf(-0.60653066f * sigmoidf_(w0[q] + v[q]));
            }
            float* op = e.o32 + (size_t)grow * DM + gcol;
            *(float4*)op = make_float4(o[0], o[1], o[2], o[3]);
            *(float4*)(op + 4) = make_float4(o[4], o[5], o[6], o[7]);
          } else if (IS(EPI_AK)) {
            const size_t off = (size_t)grow * DM + gcol;
            float kv[8]; unpack8(*(const uint4*)(e.kbuf + off), kv);
            float4 t0 = *(const float4*)(e.v0 + gcol), t1 = *(const float4*)(e.v0 + gcol + 4);
            float a0[8] = {t0.x, t0.y, t0.z, t0.w, t1.x, t1.y, t1.z, t1.w};
            t0 = *(const float4*)(e.v1 + gcol); t1 = *(const float4*)(e.v1 + gcol + 4);
            float kkc[8] = {t0.x, t0.y, t0.z, t0.w, t1.x, t1.y, t1.z, t1.w};
            t0 = *(const float4*)(e.v2 + gcol); t1 = *(const float4*)(e.v2 + gcol + 4);
            float kac[8] = {t0.x, t0.y, t0.z, t0.w, t1.x, t1.y, t1.z, t1.w};
            float kkv[8], ss = 0.f;
#pragma unroll
            for (int q = 0; q < 8; ++q) { kkv[q] = kv[q] * kkc[q]; ss += kkv[q] * kkv[q]; }
            ss += __shfl_xor(ss, 1); ss += __shfl_xor(ss, 2); ss += __shfl_xor(ss, 4);
            const float inv = fminf(__builtin_amdgcn_rsqf(ss), 1e12f);
            float o1[8], o2[8], o3[8];
#pragma unroll
            for (int q = 0; q < 8; ++q) {
              const float aa = sigmoidf_(a0[q] + v[q]);
              const float kkn = kkv[q] * inv;
              o1[q] = kv[q] * (1.f + (aa - 1.f) * kac[q]);
              o2[q] = kkn;
              o3[q] = kkn * aa;
            }
            *(uint4*)(e.kbuf + off) = pack8(o1);
            *(uint4*)(e.kkbuf + off) = pack8(o2);
            *(uint4*)(e.abbuf + off) = pack8(o3);
          } else if (IS(EPI_RESID)) {
            const size_t off = (size_t)grow * DM + gcol;
            const float* gp = e.gate + (size_t)(grow >> 13) * MODLD + gcol;
            float rv[8];
            if (e.res) {
              float4 r0v = *(const float4*)(e.res + off), r1v = *(const float4*)(e.res + off + 4);
              rv[0] = r0v.x; rv[1] = r0v.y; rv[2] = r0v.z; rv[3] = r0v.w; rv[4] = r1v.x; rv[5] = r1v.y; rv[6] = r1v.z; rv[7] = r1v.w;
            } else {
              unpack8(*(const uint4*)(e.kbuf + off), rv);
            }
            float4 g0 = *(const float4*)gp, g1 = *(const float4*)(gp + 4);
            const float gg[8] = {g0.x, g0.y, g0.z, g0.w, g1.x, g1.y, g1.z, g1.w};
            float o[8];
#pragma unroll
            for (int q = 0; q < 8; ++q) o[q] = rv[q] + gg[q] * v[q];
            if (e.o32) {
              *(float4*)(e.o32 + off) = make_float4(o[0], o[1], o[2], o[3]);
              *(float4*)(e.o32 + off + 4) = make_float4(o[4], o[5], o[6], o[7]);
            } else {
              *(uint4*)(e.o16 + off) = pack8(o);
            }
          } else if (IS(EPI_HEADNORM)) {
            float ss = 0.f;
#pragma unroll
            for (int q = 0; q < 8; ++q) ss += v[q] * v[q];
            ss += __shfl_xor(ss, 1); ss += __shfl_xor(ss, 2); ss += __shfl_xor(ss, 4);
            const float rs = rsqrtf(ss * (1.f / 64.f) + 1e-6f);
            float4 t0 = *(const float4*)(e.v0 + (gcol & 63)), t1 = *(const float4*)(e.v0 + (gcol & 63) + 4);
            float gn[8] = {t0.x, t0.y, t0.z, t0.w, t1.x, t1.y, t1.z, t1.w};
#pragma unroll
            for (int q = 0; q < 8; ++q) v[q] = v[q] * rs * gn[q];
            *(uint4*)(e.o16 + (size_t)grow * DM + gcol) = pack8(v);
          }
        }
      }
    }
}

#undef SA
#undef SB
#undef STAGE
#undef LDA
#undef LDB
#undef MMA
#undef WAIT_V
#undef WAIT_L
#undef BAR
#undef SCHED

__device__ __forceinline__ int tile_remap(int i) {
  const int G = gridDim.x;
  const int b = i % G, r = i / G;
  const int per = G >> 3;
  return r * G + (b & 7) * per + (b >> 3);
}

typedef float v2f __attribute__((ext_vector_type(2)));
constexpr int SC_TC = 16;
constexpr int SC_BUF = 5 * SC_TC * 64 * 4 + SC_TC * 16 * 4;
struct ScanRegs { uint4 a, b; float4 d; uint2 v; };

__device__ __forceinline__ void phase_scan(const Params& p, unsigned char* smem) {
  if (blockIdx.x >= 256) return;
  const int sb = blockIdx.x, bh = sb & 63, rg = sb >> 6;
  const int b = bh >> 4, h = bh & 15;
  const size_t base = (size_t)b * TT * DM + h * 64;
  const u16* Rb = (const u16*)(p.ws + SLOT(6));
  const u16* Kb = (const u16*)DSLOT(p, 0);
  const u16* Vb = (const u16*)DSLOT(p, 1);
  const u16* KKb = (const u16*)(p.ws + SLOT(3));
  const u16* ABb = (const u16*)(p.ws + SLOT(4));
  const float* DECb = (const float*)(p.ws + SLOT(1));
  u16* Yb = (u16*)(p.ws + SLOT(0));
  if (threadIdx.x >= 256) {
    const int tid = threadIdx.x - 256;
    const int ls = (tid & 127) >> 3, lc8 = tid & 7, pair = tid >> 7;
    const u16* pa = (pair ? KKb : Rb) + base + (size_t)ls * DM + lc8 * 8;
    const u16* pb = (pair ? ABb : Kb) + base + (size_t)ls * DM + lc8 * 8;
    const float* pd = DECb + base + (size_t)(tid >> 4) * DM + (tid & 15) * 4;
    const u16* pv = Vb + base + (size_t)((tid & 63) >> 2) * DM + rg * 16 + (tid & 3) * 4;
    auto gload = [&](ScanRegs& R, int t0) {
      const size_t o = (size_t)t0 * DM;
      R.a = *(const uint4*)(pa + o);
      R.b = *(const uint4*)(pb + o);
      R.d = *(const float4*)(pd + o);
      R.v = *(const uint2*)(pv + o);
    };
    auto lstore = [&](const ScanRegs& R, int buf) {
      float* L = (float*)(smem + buf * SC_BUF);
      float* la = L + (pair ? 2 : 0) * (SC_TC * 64) + ls * 64 + lc8 * 8;
      float* lb = L + (pair ? 3 : 1) * (SC_TC * 64) + ls * 64 + lc8 * 8;
      const float sg = pair ? -1.f : 1.f;
      *(float4*)(la) = make_float4(sg * bflo(R.a.x), sg * bfhi(R.a.x), sg * bflo(R.a.y), sg * bfhi(R.a.y));
      *(float4*)(la + 4) = make_float4(sg * bflo(R.a.z), sg * bfhi(R.a.z), sg * bflo(R.a.w), sg * bfhi(R.a.w));
      *(float4*)(lb) = make_float4(bflo(R.b.x), bfhi(R.b.x), bflo(R.b.y), bfhi(R.b.y));
      *(float4*)(lb + 4) = make_float4(bflo(R.b.z), bfhi(R.b.z), bflo(R.b.w), bfhi(R.b.w));
      *(float4*)(L + 4 * (SC_TC * 64) + (tid >> 4) * 64 + (tid & 15) * 4) = R.d;
      if (tid < 64) *(float4*)(L + 5 * (SC_TC * 64) + (tid >> 2) * 16 + (tid & 3) * 4) = make_float4(bflo(R.v.x), bfhi(R.v.x), bflo(R.v.y), bfhi(R.v.y));
    };
    ScanRegs X, Y;
    gload(X, 0);
    lstore(X, 0);
    gload(X, SC_TC);
    gload(Y, 2 * SC_TC);
    __syncthreads();
#pragma unroll 1
    for (int t0 = 0; t0 < TT; t0 += 2 * SC_TC) {
      lstore(X, 1);
      gload(X, min(t0 + 3 * SC_TC, TT - SC_TC));
      __syncthreads();
      lstore(Y, 0);
      gload(Y, min(t0 + 4 * SC_TC, TT - SC_TC));
      __syncthreads();
    }
  } else {
    const int tid = threadIdx.x, w = tid >> 6, lane = tid & 63;
    const int rl = lane >> 4, cl = lane & 15;
    const int row = rg * 16 + w * 4 + rl;
    u16* yp = Yb + base + row + (size_t)cl * DM;
    float S0 = 0.f, S1 = 0.f, S2 = 0.f, S3 = 0.f;
    struct StepIn { float4 r4, k4, n4, b4, d4; float v; };
    auto ldsload = [&](const float* L, int s) {
      StepIn q;
      q.n4 = *(const float4*)(L + 2 * (SC_TC * 64) + s * 64 + cl * 4);
      q.b4 = *(const float4*)(L + 3 * (SC_TC * 64) + s * 64 + cl * 4);
      q.d4 = *(const float4*)(L + 4 * (SC_TC * 64) + s * 64 + cl * 4);
      q.k4 = *(const float4*)(L + 1 * (SC_TC * 64) + s * 64 + cl * 4);
      q.v = L[5 * (SC_TC * 64) + s * 16 + w * 4 + rl];
      q.r4 = *(const float4*)(L + 0 * (SC_TC * 64) + s * 64 + cl * 4);
      return q;
    };
    float rp0 = 0.f, rp1 = 0.f, rp2 = 0.f, rp3 = 0.f;
    float yacc = 0.f;
    auto step = [&](const StepIn& c) -> float {
      float t0, t1, y0, y1, u0, u1, u2, u3;
      asm volatile(
          "v_mul_f32 %0, %8, %12\n\t"
          "v_mul_f32 %2, %8, %16\n\t"
          "v_mul_f32 %1, %10, %14\n\t"
          "v_mul_f32 %3, %10, %18\n\t"
          "v_fmac_f32 %0, %9, %13\n\t"
          "v_fmac_f32 %2, %9, %17\n\t"
          "v_fmac_f32 %1, %11, %15\n\t"
          "v_fmac_f32 %3, %11, %19\n\t"
          "v_add_f32 %0, %0, %1\n\t"
          "v_add_f32 %2, %2, %3\n\t"
          "v_mul_f32 %4, %20, %21\n\t"
          "v_add_f32_dpp %0, %0, %0 quad_perm:[1,0,3,2] row_mask:0xf bank_mask:0xf bound_ctrl:1\n\t"
          "v_add_f32_dpp %2, %2, %2 quad_perm:[1,0,3,2] row_mask:0xf bank_mask:0xf bound_ctrl:1\n\t"
          "v_mul_f32 %5, %20, %22\n\t"
          "v_add_f32_dpp %0, %0, %0 quad_perm:[2,3,0,1] row_mask:0xf bank_mask:0xf bound_ctrl:1\n\t"
          "v_add_f32_dpp %2, %2, %2 quad_perm:[2,3,0,1] row_mask:0xf bank_mask:0xf bound_ctrl:1\n\t"
          "v_mul_f32 %6, %20, %23\n\t"
          "v_add_f32_dpp %0, %0, %0 row_ror:4 row_mask:0xf bank_mask:0xf bound_ctrl:1\n\t"
          "v_add_f32_dpp %2, %2, %2 row_ror:4 row_mask:0xf bank_mask:0xf bound_ctrl:1\n\t"
          "v_mul_f32 %7, %20, %24\n\t"
          "v_add_f32_dpp %0, %0, %0 row_ror:8 row_mask:0xf bank_mask:0xf bound_ctrl:1\n\t"
          "v_add_f32_dpp %2, %2, %2 row_ror:8 row_mask:0xf bank_mask:0xf bound_ctrl:1\n\t"
          : "=&v"(t0), "=&v"(t1), "=&v"(y0), "=&v"(y1), "=&v"(u0), "=&v"(u1), "=&v"(u2), "=&v"(u3)
          : "v"(S0), "v"(S1), "v"(S2), "v"(S3), "v"(c.n4.x), "v"(c.n4.y), "v"(c.n4.z), "v"(c.n4.w),
            "v"(rp0), "v"(rp1), "v"(rp2), "v"(rp3), "v"(c.v), "v"(c.k4.x), "v"(c.k4.y), "v"(c.k4.z), "v"(c.k4.w));
      asm volatile(
          "v_fmac_f32 %4, %8, %9\n\t"
          "v_fmac_f32 %5, %8, %10\n\t"
          "v_fmac_f32 %6, %8, %11\n\t"
          "v_fmac_f32 %7, %8, %12\n\t"
          "v_fma_f32 %0, %0, %13, %4\n\t"
          "v_fma_f32 %1, %1, %14, %5\n\t"
          "v_fma_f32 %2, %2, %15, %6\n\t"
          "v_fma_f32 %3, %3, %16, %7\n\t"
          : "+v"(S0), "+v"(S1), "+v"(S2), "+v"(S3), "+v"(u0), "+v"(u1), "+v"(u2), "+v"(u3)
          : "v"(t0), "v"(c.b4.x), "v"(c.b4.y), "v"(c.b4.z), "v"(c.b4.w), "v"(c.d4.x), "v"(c.d4.y), "v"(c.d4.z), "v"(c.d4.w));
      rp0 = c.r4.x; rp1 = c.r4.y; rp2 = c.r4.z; rp3 = c.r4.w;
      return y0;
    };
    auto compute = [&](int buf, int t0) {
      const float* L = (const float*)(smem + buf * SC_BUF);
      StepIn cur = ldsload(L, 0);
#pragma unroll
      for (int s = 0; s < SC_TC; ++s) {
        StepIn nxt = cur;
        if (s + 1 < SC_TC) nxt = ldsload(L, s + 1);
        const float y = step(cur);
        if (s == 0) {
          yacc = (cl == 15) ? y : yacc;
          if (t0 > 0) yp[(size_t)(t0 - SC_TC) * DM] = f2bf(yacc);
        } else {
          yacc = (cl == s - 1) ? y : yacc;
        }
        cur = nxt;
        if ((s & 3) == 3) __builtin_amdgcn_sched_barrier(0);
      }
    };
    __syncthreads();
#pragma unroll 1
    for (int t0 = 0; t0 < TT; t0 += 2 * SC_TC) {
      compute(0, t0);
      __syncthreads();
      compute(1, t0 + SC_TC);
      __syncthreads();
    }
    {
      float y = (S0 * rp0 + S1 * rp1) + (S2 * rp2 + S3 * rp3);
      y = allreduce16(y);
      yacc = (cl == 15) ? y : yacc;
      yp[(size_t)(TT - SC_TC) * DM] = f2bf(yacc);
    }
  }
}

__device__ __forceinline__ void phase_gn(const Params& p) {
  const u16* R = (const u16*)(p.ws + SLOT(6));
  const u16* Kp = (const u16*)DSLOT(p, 0);
  const u16* V = (const u16*)DSLOT(p, 1);
  const u16* G = (const u16*)(p.ws + SLOT(5));
  u16* Y = (u16*)(p.ws + SLOT(0));
  const float* rk = p.in[17];
  const float* lg = p.in[18];
  const float* lb = p.in[19];
  const size_t nchunks = (size_t)MT * 128;
  const size_t stride = (size_t)gridDim.x * NT;
  for (size_t q = (size_t)blockIdx.x * NT + threadIdx.x; q < nchunks; q += stride) {
    const size_t off = q * 8;
    const int c = (int)(off & (DM - 1));
    float y[8], r[8], k[8], v[8], g[8];
    unpack8(*(const uint4*)(Y + off), y); unpack8(*(const uint4*)(R + off), r); unpack8(*(const uint4*)(Kp + off), k);
    unpack8(*(const uint4*)(V + off), v); unpack8(*(const uint4*)(G + off), g);
    float s = 0.f, rks = 0.f;
#pragma unroll
    for (int i = 0; i < 8; ++i) { s += y[i]; rks += r[i] * k[i] * rk[c + i]; }
    s += __shfl_xor(s, 1); s += __shfl_xor(s, 2); s += __shfl_xor(s, 4);
    rks += __shfl_xor(rks, 1); rks += __shfl_xor(rks, 2); rks += __shfl_xor(rks, 4);
    const float mean = s * (1.f / 64.f);
    float vs = 0.f;
#pragma unroll
    for (int i = 0; i < 8; ++i) { float d = y[i] - mean; vs += d * d; }
    vs += __shfl_xor(vs, 1); vs += __shfl_xor(vs, 2); vs += __shfl_xor(vs, 4);
    const float rstd = rsqrtf(vs * (1.f / 64.f) + 64e-5f);
    float z[8];
#pragma unroll
    for (int i = 0; i < 8; ++i) z[i] = ((y[i] - mean) * rstd * lg[c + i] + lb[c + i] + rks * v[i]) * g[i];
    *(uint4*)(Y + off) = pack8(z);
  }
}

__device__ __forceinline__ void phase_kmean(const Params& p) {
  const u16* Kb = (const u16*)(p.ws + SLOT(1));
  float* km = (float*)(p.ws + OFF_KMEAN);
  const int lane = threadIdx.x & 63;
  const int gw = blockIdx.x * NWV + (threadIdx.x >> 6), nw = gridDim.x * NWV;
  for (int it = gw; it < 2048; it += nw) {
    const int bh = it >> 5, n = it & 31, b = bh >> 4, h = bh & 15;
    const u16* kp = Kb + ((size_t)b * TT + n * 256 + (lane >> 3)) * DM + h * 64 + (lane & 7) * 8;
    float s[8] = {0.f, 0.f, 0.f, 0.f, 0.f, 0.f, 0.f, 0.f};
#pragma unroll 8
    for (int j = 0; j < 32; ++j) {
      float f[8]; unpack8(*(const uint4*)(kp + (size_t)j * 8 * DM), f);
#pragma unroll
      for (int q = 0; q < 8; ++q) s[q] += f[q];
    }
#pragma unroll
    for (int q = 0; q < 8; ++q) { s[q] += __shfl_xor(s[q], 8); s[q] += __shfl_xor(s[q], 16); s[q] += __shfl_xor(s[q], 32); }
    if (lane < 8) {
      float* o = km + (size_t)it * 64 + lane * 8;
      *(float4*)o = make_float4(s[0] * (1.f / 256.f), s[1] * (1.f / 256.f), s[2] * (1.f / 256.f), s[3] * (1.f / 256.f));
      *(float4*)(o + 4) = make_float4(s[4] * (1.f / 256.f), s[5] * (1.f / 256.f), s[6] * (1.f / 256.f), s[7] * (1.f / 256.f));
    }
  }
}

__device__ __forceinline__ void phase_gate(const Params& p) {
  const u16* Q = (const u16*)(p.ws + SLOT(4));
  const float* km = (const float*)(p.ws + OFF_KMEAN);
  int* cnt = (int*)(p.ws + OFF_CNT);
  u16* lists = (u16*)(p.ws + SLOT(5));
  float* lse = (float*)(p.ws + OFF_LSE);
  const int lane = threadIdx.x & 63;
  const int gw = blockIdx.x * NWV + (threadIdx.x >> 6), nw = gridDim.x * NWV;
  for (int it0 = gw; it0 < 8192; it0 += nw) {
    const int it = __builtin_amdgcn_readfirstlane(it0);
    const int bh = it >> 7, qg = it & 127, b = bh >> 4, h = bh & 15;
    const int blk = qg >> 2;
    const int t = qg * 64 + lane;
    const size_t m = (size_t)b * TT + t;
    float q[64];
    {
      const uint4* qp = (const uint4*)(Q + m * DM + h * 64);
#pragma unroll
      for (int i = 0; i < 8; ++i) unpack8(qp[i], q + 8 * i);
    }
    float s0 = -3e38f, s1 = -3e38f, s2 = -3e38f;
    int i0 = 0, i1 = 0, i2 = 0;
    for (int n = 0; n < blk; ++n) {
      const float* kr = km + ((size_t)bh * 32 + n) * 64;
      float s = 0.f;
#pragma unroll
      for (int d = 0; d < 64; ++d) s += q[d] * kr[d];
      if (s > s0) { s2 = s1; i2 = i1; s1 = s0; i1 = i0; s0 = s; i0 = n; }
      else if (s > s1) { s2 = s1; i2 = i1; s1 = s; i1 = n; }
      else if (s > s2) { s2 = s; i2 = n; }
    }
    const int nsel = min(3, blk);
    unsigned long long mymask = 0ull;
    for (int n = 0; n < blk; ++n) {
      const bool sel = (i0 == n) || (nsel > 1 && i1 == n) || (nsel > 2 && i2 == n);
      const unsigned long long mk = __ballot(sel);
      if (lane == n) mymask = mk;
    }
    const int tot = __popcll(mymask);
    int base = 0;
    if (lane < blk && tot > 0) base = atomicAdd(&cnt[bh * 32 + lane], tot);
    const unsigned mlo = (unsigned)mymask, mhi = (unsigned)(mymask >> 32);
    const unsigned long long below = (1ull << lane) - 1ull;
#pragma unroll
    for (int s = 0; s < 3; ++s) {
      const int n = (s == 0) ? i0 : (s == 1) ? i1 : i2;
      const unsigned lo = __shfl(mlo, n), hi = __shfl(mhi, n);
      const int bs = __shfl(base, n);
      if (s < nsel) {
        const unsigned long long mk = ((unsigned long long)hi << 32) | lo;
        const int pos = bs + __popcll(mk & below);
        lists[(size_t)(bh * 32 + n) * 8192 + pos] = (u16)(t | (s << 13));
      } else {
        lse[(size_t)s * MT * 16 + m * 16 + h] = -1e30f;
      }
    }
  }
}

constexpr int VT_LD = 528;
__device__ __forceinline__ int swz(int row, int chunk) { return row * 128 + ((chunk ^ ((row >> 1) & 7)) << 4); }

template <bool OWN>
__device__ __forceinline__ void attn_tile(const bf16x8 q0, const bf16x8 q1, int tloc, const unsigned char* smem,
                                          float& mout, float& lout, f32x4 O[4]) {
  const int lane = threadIdx.x & 63, g = lane >> 4, c16 = lane & 15;
  f32x4 S[16];
#pragma unroll
  for (int kt = 0; kt < 16; ++kt) {
    const int row = kt * 16 + c16;
    bf16x8 k0 = *(const bf16x8*)(smem + swz(row, g));
    bf16x8 k1 = *(const bf16x8*)(smem + swz(row, g + 4));
    f32x4 z = (f32x4){0.f, 0.f, 0.f, 0.f};
    z = __builtin_amdgcn_mfma_f32_16x16x32_bf16(k0, q0, z, 0, 0, 0);
    z = __builtin_amdgcn_mfma_f32_16x16x32_bf16(k1, q1, z, 0, 0, 0);
    S[kt] = z;
    if ((kt & 3) == 3) __builtin_amdgcn_sched_barrier(0);
  }
  float mx = -3e38f;
#pragma unroll
  for (int kt = 0; kt < 16; ++kt)
#pragma unroll
    for (int r = 0; r < 4; ++r) {
      float s = S[kt][r] * (0.125f * 1.44269504f);
      if (OWN) { if (kt * 16 + 4 * g + r > tloc) s = -3e38f; }
      S[kt][r] = s;
      mx = fmaxf(mx, s);
    }
  mx = fmaxf(mx, __shfl_xor(mx, 16));
  mx = fmaxf(mx, __shfl_xor(mx, 32));
  float l = 0.f;
#pragma unroll
  for (int kt = 0; kt < 16; ++kt)
#pragma unroll
    for (int r = 0; r < 4; ++r) {
      float pv = __builtin_amdgcn_exp2f(S[kt][r] - mx);
      S[kt][r] = pv;
      l += pv;
    }
  l += __shfl_xor(l, 16);
  l += __shfl_xor(l, 32);
#pragma unroll
  for (int dt = 0; dt < 4; ++dt) O[dt] = (f32x4){0.f, 0.f, 0.f, 0.f};
  const unsigned char* vb = smem + 32768;
#pragma unroll
  for (int j = 0; j < 8; ++j) {
    union { bf16x8 v; unsigned u[4]; } pf;
    pf.u[0] = pack2(S[2 * j][0], S[2 * j][1]);
    pf.u[1] = pack2(S[2 * j][2], S[2 * j][3]);
    pf.u[2] = pack2(S[2 * j + 1][0], S[2 * j + 1][1]);
    pf.u[3] = pack2(S[2 * j + 1][2], S[2 * j + 1][3]);
#pragma unroll
    for (int dt = 0; dt < 4; ++dt) {
      const unsigned char* vp = vb + (dt * 16 + c16) * VT_LD + (32 * j + 4 * g) * 2;
      union { bf16x8 v; uint2 h[2]; } vf;
      vf.h[0] = *(const uint2*)(vp);
      vf.h[1] = *(const uint2*)(vp + 32);
      O[dt] = __builtin_amdgcn_mfma_f32_16x16x32_bf16(vf.v, pf.v, O[dt], 0, 0, 0);
    }
    if (j & 1) __builtin_amdgcn_sched_barrier(0);
  }
  mout = mx * 0.69314718f; lout = l;
}

__device__ __forceinline__ u16* part_ptr(const Params& p, int slot) {
  return (u16*)(p.ws + (slot == 0 ? SLOT(0) : slot == 1 ? SLOT(3) : SLOT(6)));
}

struct AItem { int li, seg, b, h, n, c; };

template <bool OWN>
__device__ __forceinline__ void phase_attn(const Params& p, unsigned char* smem) {
  const int tid = threadIdx.x, lane = tid & 63, w = tid >> 6, g = lane >> 4, c16 = lane & 15;
  const int G = gridDim.x;
  const int* cnt = (const int*)(p.ws + OFF_CNT);
  const u16* lists = (const u16*)(p.ws + SLOT(5));
  u16* Q = (u16*)(p.ws + SLOT(4));
  float* lse = (float*)(p.ws + OFF_LSE);
  int* offs = (int*)(smem + 66560);
  unsigned char* Qs = smem + 75008;
  unsigned* entl = (unsigned*)(smem + 75008 + 16384);
  int total = 4096;
  if (!OWN) {
    int* part = (int*)smem;
    int loc[4]; int s = 0;
#pragma unroll
    for (int i = 0; i < 4; ++i) { loc[i] = (cnt[tid * 4 + i] + 127) >> 7; s += loc[i]; }
    part[tid] = s;
    __syncthreads();
    if (tid == 0) { int a = 0; for (int i = 0; i < NT; ++i) { int v = part[i]; part[i] = a; a += v; } offs[2048] = a; }
    __syncthreads();
    int a = part[tid];
#pragma unroll
    for (int i = 0; i < 4; ++i) { offs[tid * 4 + i] = a; a += loc[i]; }
    __syncthreads();
    total = offs[2048];
  }
  const int Jp = (total + G - 1) / G;
  const int it0 = (int)blockIdx.x * Jp;
  if (it0 >= total) return;
  const int J = min(Jp, total - it0);
  int* itab = (int*)(smem + 75008 + 16384 + 512);
  int* ctab = itab + 1024;
  if (!OWN) {
    for (int j = tid; j < J; j += NT) {
      const int it_ = it0 + j;
      int lo = 0, hi = 2048;
      while (hi - lo > 1) { int mid = (lo + hi) >> 1; if (offs[mid] <= it_) lo = mid; else hi = mid; }
      itab[j] = lo | ((it_ - offs[lo]) << 11);
      ctab[j] = cnt[lo];
    }
    __syncthreads();
  }

  auto decode = [&](int j) {
    AItem d;
    if (OWN) { const int it = it0 + j; d.li = it >> 1; d.seg = it & 1; d.c = 0; }
    else {
      const int pk = itab[j];
      d.li = pk & 2047; d.seg = pk >> 11; d.c = ctab[j];
    }
    const int bh = d.li >> 5;
    d.n = d.li & 31; d.b = bh >> 4; d.h = bh & 15;
    return d;
  };
  auto load_ent1 = [&](const AItem& d, const int i) -> unsigned {
    const int row = (tid >> 3) + 64 * i;
    if (OWN) return (unsigned)(d.n * 256 + d.seg * 128 + row) | 0x8000u;
    const int qi = d.seg * 128 + row;
    const int qc = min(qi, 8191);
    unsigned v = lists[(size_t)d.li * 8192 + qc];
    return (qi < d.c) ? (v | 0x8000u) : 0u;
  };
  uint4 kr0, kr1, kr2, kr3, vr0, vr1, vr2, vr3, qr0, qr1;
  auto load_kvq = [&](const AItem& d, const unsigned e0, const unsigned e1, const bool ldkv) {
    const u16* Kb = (const u16*)(p.ws + SLOT(1)) + ((size_t)d.b * TT + d.n * 256) * DM + d.h * 64;
    const u16* Vt = (const u16*)(p.ws + SLOT(2)) + (size_t)(((d.b * 16 + d.h) * 32 + d.n) * 64) * 256;
#define LDKV(i, K_, V_) { const int idx = tid + NT * (i); K_ = *(const uint4*)(Kb + (size_t)(idx >> 3) * DM + (idx & 7) * 8); V_ = *(const uint4*)(Vt + (size_t)idx * 8); }
    if (ldkv) { LDKV(0, kr0, vr0) LDKV(1, kr1, vr1) LDKV(2, kr2, vr2) LDKV(3, kr3, vr3) }
#undef LDKV
    qr0 = *(const uint4*)(Q + ((size_t)d.b * TT + (e0 & 8191u)) * DM + d.h * 64 + (tid & 7) * 8);
    qr1 = *(const uint4*)(Q + ((size_t)d.b * TT + (e1 & 8191u)) * DM + d.h * 64 + (tid & 7) * 8);
  };
  auto store_lds = [&](const unsigned e0, const unsigned e1, const bool stkv) {
#define STKV(i, K_, V_) { const int idx = tid + NT * (i); *(uint4*)(smem + swz(idx >> 3, idx & 7)) = K_; *(uint4*)(smem + 32768 + (idx >> 5) * VT_LD + (idx & 31) * 16) = V_; }
    if (stkv) { STKV(0, kr0, vr0) STKV(1, kr1, vr1) STKV(2, kr2, vr2) STKV(3, kr3, vr3) }
#undef STKV
    *(uint4*)(Qs + swz(tid >> 3, tid & 7)) = qr0;
    *(uint4*)(Qs + swz((tid >> 3) + 64, tid & 7)) = qr1;
    if ((tid & 7) == 0) { entl[tid >> 3] = e0; entl[(tid >> 3) + 64] = e1; }
  };

  int it = 0;
  AItem dc = decode(0);
  unsigned ec0 = load_ent1(dc, 0), ec1 = load_ent1(dc, 1);
  load_kvq(dc, ec0, ec1, true);
  bool newkv = true;
  int itn = min(1, J - 1);
  AItem dn = decode(itn);
  unsigned en0 = load_ent1(dn, 0), en1 = load_ent1(dn, 1);
  while (true) {
    __syncthreads();
    store_lds(ec0, ec1, newkv);
    __syncthreads();
    newkv = (dn.li != dc.li);
    load_kvq(dn, en0, en1, newkv);
    ec0 = en0; ec1 = en1;
    const AItem d = dc;
    dc = dn;
    itn = min(itn + 1, J - 1);
    dn = decode(itn);
    en0 = load_ent1(dn, 0); en1 = load_ent1(dn, 1);
    {
      const int row = w * 16 + c16;
      const unsigned ent = entl[row];
      const bool valid = (ent >> 15) != 0;
      const int t = ent & 8191, slot = (ent >> 13) & 3;
      const size_t m = (size_t)d.b * TT + t;
      const bf16x8 q0 = *(const bf16x8*)(Qs + swz(row, g));
      const bf16x8 q1 = *(const bf16x8*)(Qs + swz(row, g + 4));
      float mx, l; f32x4 O[4];
      attn_tile<OWN>(q0, q1, d.seg * 128 + row, smem, mx, l, O);
      if (!OWN) {
        if (valid) {
          const float inv = frcp_(l);
          u16* po = part_ptr(p, slot) + m * DM + d.h * 64;
#pragma unroll
          for (int dt = 0; dt < 4; ++dt) {
            uint2 o;
            o.x = pack2(O[dt][0] * inv, O[dt][1] * inv);
            o.y = pack2(O[dt][2] * inv, O[dt][3] * inv);
            *(uint2*)(po + dt * 16 + 4 * g) = o;
          }
          if (g == 0) lse[(size_t)slot * MT * 16 + m * 16 + d.h] = mx + __logf(l);
        }
      } else {
        float ls[3], M2 = mx;
#pragma unroll
        for (int s = 0; s < 3; ++s) { ls[s] = lse[(size_t)s * MT * 16 + m * 16 + d.h]; M2 = fmaxf(M2, ls[s]); }
        const float wo = __expf(mx - M2);
        float ws[3], den = l * wo;
#pragma unroll
        for (int s = 0; s < 3; ++s) { ws[s] = (ls[s] > -1e29f) ? __expf(ls[s] - M2) : 0.f; den += ws[s]; }
        const float inv = frcp_(den);
#pragma unroll
        for (int dt = 0; dt < 4; ++dt) {
          float o0 = O[dt][0] * wo, o1 = O[dt][1] * wo, o2 = O[dt][2] * wo, o3 = O[dt][3] * wo;
#pragma unroll
          for (int s = 0; s < 3; ++s) {
            if (ws[s] != 0.f) {
              const u16* pp = part_ptr(p, s) + m * DM + d.h * 64 + dt * 16 + 4 * g;
              uint2 u = *(const uint2*)pp;
              o0 += ws[s] * bflo(u.x); o1 += ws[s] * bfhi(u.x); o2 += ws[s] * bflo(u.y); o3 += ws[s] * bfhi(u.y);
            }
          }
          uint2 o;
          o.x = pack2(o0 * inv, o1 * inv);
          o.y = pack2(o2 * inv, o3 * inv);
          *(uint2*)(Q + m * DM + d.h * 64 + dt * 16 + 4 * g) = o;
        }
      }
    }
    it += 1;
    if (it >= J) break;
  }
}

#define TILE_LOOP(total) for (int _i = blockIdx.x, _G = gridDim.x, _tot = (total), _end = ((_tot + _G - 1) / _G) * _G; _i < _end; _i += _G)

#define EB(x) (1 << (x))
struct TileD { const u16* A; const u16* B; int brow, bcol, epi; u16* o16; int ldo; const float* v0; };

__device__ __forceinline__ TileD rkv_tile(const Params& p, int i) {
  const u16* wt = (const u16*)p.ws;
  const int tile = tile_remap(i);
  const int s = tile >> 9, rem = tile & 511, mt = rem >> 2, nt = rem & 3;
  TileD t;
  t.A = (const u16*)(p.ws + SLOT(s)); t.B = wt + WT_RKV + (size_t)s * M1; t.brow = mt * 256; t.bcol = nt * 256; t.epi = EPI_BF16;
  t.o16 = (s == 0) ? (u16*)(p.ws + SLOT(6)) : (u16*)DSLOT(p, s - 1); t.ldo = DM; t.v0 = nullptr;
  return t;
}
__device__ __forceinline__ void phase_rkv(const Params& p, unsigned char* smem) {
  const int G = gridDim.x, total = 1536;
  for (int i = blockIdx.x; i < total; i += G) {
    const TileD t = rkv_tile(p, i);
    const bool has_next = (i + G) < total;
    const TileD n = rkv_tile(p, has_next ? i + G : i);
    Epi e{};
    e.o16 = t.o16; e.ldo = t.ldo;
    gemm_tile<EB(EPI_BF16), true>(t.A, t.B, DM, t.brow, t.bcol, EPI_BF16, e, smem, i == (int)blockIdx.x, has_next, n.A, n.B, n.brow, n.bcol);
  }
  __syncthreads();
}

__device__ __forceinline__ TileD lora1_tile(const Params& p, int tile) {
  const u16* wt = (const u16*)p.ws;
  const int j = tile >> 7, mt = tile & 127;
  TileD t;
  t.A = (const u16*)(p.ws + SLOT(3 + j)); t.B = wt + WT_W1 + (size_t)j * 256 * 1024; t.brow = mt * 256; t.bcol = 0;
  t.epi = (j == 0) ? EPI_TANH : (j == 1) ? EPI_BF16 : EPI_SIG;
  t.o16 = (u16*)(p.ws + SLOT(0)) + (size_t)j * MT * 256; t.ldo = 256; t.v0 = nullptr;
  return t;
}
__device__ __forceinline__ void phase_lora1(const Params& p, unsigned char* smem) {
  const int G = gridDim.x, total = 384;
  for (int i = blockIdx.x; i < total; i += G) {
    const TileD t = lora1_tile(p, i);
    const bool has_next = (i + G) < total;
    const TileD n = lora1_tile(p, has_next ? i + G : i);
    Epi e{};
    e.o16 = t.o16; e.ldo = t.ldo;
    gemm_tile<EB(EPI_TANH) | EB(EPI_BF16) | EB(EPI_SIG), true>(t.A, t.B, DM, t.brow, t.bcol, t.epi, e, smem,
                                                              i == (int)blockIdx.x, has_next, n.A, n.B, n.brow, n.bcol);
  }
  __syncthreads();
}

__device__ __forceinline__ void phase_lora2(const Params& p, unsigned char* smem) {
  const u16* wt = (const u16*)p.ws;
  const u16* lora = (const u16*)(p.ws + SLOT(0));
  TILE_LOOP(1536) {
    const int tile = tile_remap(_i);
    if (tile >= 1536) continue;
    const int which = tile >> 9, rem = tile & 511, mt = rem >> 2, nt = rem & 3;
    Epi e{};
    e.o32 = (float*)(p.ws + SLOT(1));
    e.v0 = (which == 0) ? p.in[7] : p.in[10]; e.v1 = p.in[15]; e.v2 = p.in[16];
    e.kbuf = (u16*)DSLOT(p, 0); e.kkbuf = (u16*)(p.ws + SLOT(3)); e.abbuf = (u16*)(p.ws + SLOT(4));
    e.o16 = (u16*)(p.ws + SLOT(5)); e.ldo = DM;
    const int epi = (which == 0) ? EPI_DECAY : (which == 1) ? EPI_AK : EPI_BF16;
    gemm_tile<EB(EPI_DECAY) | EB(EPI_AK) | EB(EPI_BF16)>(lora + (size_t)which * MT * 256, wt + WT_W2 + (size_t)which * 256 * 1024, 256,
                                                        mt * 256, nt * 256, epi, e, smem);
  }
}

__device__ __forceinline__ void phase_resid(const Params& p, const u16* A, int K, const u16* Bt, const float* res32, const u16* res16,
                                            float* out32, u16* out16, int gate_off, unsigned char* smem) {
  const float* mod = (const float*)(p.ws + OFF_MOD);
  TILE_LOOP(512) {
    const int tile = tile_remap(_i);
    if (tile >= 512) continue;
    const int mt = tile >> 2, nt = tile & 3;
    Epi e{};
    e.o32 = out32; e.o16 = out16; e.res = res32; e.kbuf = (u16*)res16; e.gate = mod + gate_off;
    gemm_tile<EB(EPI_RESID)>(A, Bt, K, mt * 256, nt * 256, EPI_RESID, e, smem);
  }
}

__device__ __forceinline__ void ffn_up_coords(int i, int& mt2, int& nt2) {
  const int tile = tile_remap(i);
  const int st = tile >> 5, w = tile & 31;
  if (st < 80) { mt2 = (st / 5) * 8 + (w >> 2); nt2 = (st % 5) * 4 + (w & 3); }
  else { mt2 = (st - 80) * 16 + (w >> 1); nt2 = 20 + (w & 1); }
}
__device__ __forceinline__ void phase_ffn_up(const Params& p, const u16* A, const u16* Bt, u16* act, unsigned char* smem) {
  const int G = gridDim.x, total = 128 * 22;
  for (int i = blockIdx.x; i < total; i += G) {
    int mt2, nt2, mtn = 0, ntn = 0;
    ffn_up_coords(i, mt2, nt2);
    const bool has_next = (i + G) < total;
    if (has_next) ffn_up_coords(i + G, mtn, ntn);
    Epi e{};
    e.o16 = act;
    gemm_tile<EB(EPI_SWIGLU), true>(A, Bt, DM, mt2 * 256, nt2 * 256, EPI_SWIGLU, e, smem,
                                    i == (int)blockIdx.x, has_next, A, Bt, mtn * 256, ntn * 256);
  }
  __syncthreads();
}

__device__ __forceinline__ TileD qkv_tile(const Params& p, int i) {
  const u16* wt = (const u16*)p.ws;
  const int tile = tile_remap(i);
  const int which = tile >> 9, rem = tile & 511, mt = rem >> 2, nt = rem & 3;
  TileD t;
  t.A = (const u16*)(p.ws + (which == 2 ? SLOT(3) : SLOT(0))); t.B = wt + WT_KVK + (size_t)which * M1;
  t.brow = mt * 256; t.bcol = nt * 256; t.epi = (which == 1) ? EPI_VT : EPI_HEADNORM;
  t.o16 = (u16*)(p.ws + (which == 0 ? SLOT(1) : which == 1 ? SLOT(2) : SLOT(4))); t.ldo = DM;
  t.v0 = (which == 0) ? p.in[29] : p.in[31];
  return t;
}
__device__ __forceinline__ void phase_qkv(const Params& p, unsigned char* smem) {
  const int G = gridDim.x, total = 1536;
  for (int i = blockIdx.x; i < total; i += G) {
    const TileD t = qkv_tile(p, i);
    const bool has_next = (i + G) < total;
    const TileD n = qkv_tile(p, has_next ? i + G : i);
    Epi e{};
    e.o16 = t.o16; e.v0 = t.v0;
    gemm_tile<EB(EPI_HEADNORM) | EB(EPI_VT), true>(t.A, t.B, DM, t.brow, t.bcol, t.epi, e, smem,
                                                   i == (int)blockIdx.x, has_next, n.A, n.B, n.brow, n.bcol);
  }
  __syncthreads();
}

constexpr int NPHASES = 21;
#ifdef ONLY_PHASE
#define PEN(k) ((k) == ONLY_PHASE)
#else
#define PEN(k) true
#endif
#define RUN(k, call) if (ph0 <= (k) && (k) < ph1) { if (PEN(k)) { call; } if ((k) + 1 < ph1) grid.sync(); }

__global__ void __launch_bounds__(512, 2) mega(Params p, int ph0, int ph1) {
  __shared__ __attribute__((aligned(16))) unsigned char smem[SMEM_BYTES];
  cg::grid_group grid = cg::this_grid();
  const float* mod = (const float*)(p.ws + OFF_MOD);
  const u16* wt = (const u16*)p.ws;
  RUN(0, phase_prep(p, smem))
  RUN(1, phase_norm_xs(p))
  RUN(2, phase_rkv(p, smem))
  RUN(3, phase_lora1(p, smem))
  RUN(4, phase_lora2(p, smem))
  RUN(5, phase_scan(p, smem))
  RUN(6, phase_gn(p))
  RUN(7, phase_resid(p, (const u16*)(p.ws + SLOT(0)), DM, wt + WT_WO, p.in[0], nullptr, nullptr, (u16*)(p.ws + SLOT(1)), 2048, smem))
  RUN(8, phase_norm((const u16*)(p.ws + SLOT(1)), p.in[2] + 1024, mod, 3072, 3072 + 1024, (u16*)(p.ws + SLOT(3)), nullptr, 0, 0, nullptr))
  RUN(9, phase_ffn_up(p, (const u16*)(p.ws + SLOT(3)), wt + WT_GU, (u16*)(p.ws + SLOT(4)), smem))
  RUN(10, phase_resid(p, (const u16*)(p.ws + SLOT(4)), FF, wt + WT_DN, nullptr, (const u16*)(p.ws + SLOT(1)), nullptr, (u16*)DSLOT(p, 0), 3072 + 2048, smem))
  RUN(11, phase_norm((const u16*)DSLOT(p, 0), p.in[24], mod, 12288, 12288 + 1024, (u16*)(p.ws + SLOT(0)), p.in[2] + 2048, 6144, 6144 + 1024, (u16*)(p.ws + SLOT(3))))
  RUN(12, phase_qkv(p, smem))
  RUN(13, phase_kmean(p))
  RUN(14, phase_gate(p))
  RUN(15, phase_attn<false>(p, smem))
  RUN(16, phase_attn<true>(p, smem))
  RUN(17, phase_resid(p, (const u16*)(p.ws + SLOT(4)), DM, wt + WT_MBO, nullptr, (const u16*)DSLOT(p, 0), nullptr, (u16*)(p.ws + SLOT(5)), 6144 + 2048, smem))
  RUN(18, phase_norm((const u16*)(p.ws + SLOT(5)), p.in[2] + 3072, mod, 9216, 9216 + 1024, (u16*)(p.ws + SLOT(0)), nullptr, 0, 0, nullptr))
  RUN(19, phase_ffn_up(p, (const u16*)(p.ws + SLOT(0)), wt + WT_GU + (size_t)5632 * 1024, (u16*)(p.ws + SLOT(1)), smem))
  RUN(20, phase_resid(p, (const u16*)(p.ws + SLOT(1)), FF, wt + WT_DN + (size_t)1024 * 2816, nullptr, (const u16*)(p.ws + SLOT(5)), p.out, nullptr, 9216 + 2048, smem))
}

extern "C" void kernel_launch(void* const* d_in, const int* in_sizes, int n_in, void* d_out, int out_size,
                              void* d_ws, size_t ws_size, hipStream_t stream) {
  static int grid_blocks = 0;
  if (!grid_blocks) {
    int dev = 0, cus = 0, per_cu = 0;
    (void)hipGetDevice(&dev);
    (void)hipDeviceGetAttribute(&cus, hipDeviceAttributeMultiprocessorCount, dev);
    (void)hipOccupancyMaxActiveBlocksPerMultiprocessor(&per_cu, mega, NT, 0);
    if (per_cu < 1) per_cu = 1;
    grid_blocks = cus;
    if (grid_blocks > cus * per_cu) grid_blocks = cus * per_cu;
    grid_blocks &= ~7;
  }
  Params p{};
  for (int i = 0; i < 33; ++i) p.in[i] = (const float*)d_in[i];
  p.out = (float*)d_out;
  p.ws = (unsigned char*)d_ws;
#if SINGLE_LAUNCH
  int ph0 = 0, ph1 = NPHASES;
  void* args[] = {&p, &ph0, &ph1};
  hipError_t e = hipLaunchCooperativeKernel((void*)mega, dim3(grid_blocks), dim3(NT), args, 0, stream);
  if (e != hipSuccess) fprintf(stderr, "cooperative launch failed: %s (grid %d)\n", hipGetErrorString(e), grid_blocks);
#else
  for (int ph = 0; ph < NPHASES; ++ph) mega<<<grid_blocks, NT, 0, stream>>>(p, ph, ph + 1);
#endif
}
```
